# Optimizing an MI355X kernel written in HIP

```python
import math
import jax, jax.numpy as jnp
from jax import lax
import numpy as np

D_MODEL = 1024
BATCH = 8
SEQ = 2048
DEPTH = 2

GRID_W = 64
CTX_LEN = 256
MIX_W = 512
IN_W = 5 * MIX_W
A_CONV = 3
B_GROUPS = 8
CHUNK = 128
C_CONV = 31
D_HEADS = 4
D_HEAD_DIM = 64
ROPE_THETA = 10000.0
N_ADA = 6
PEER_HEADS = 8
PEER_KEYS = 128
PEER_EXPERTS = PEER_KEYS * PEER_KEYS
PEER_QDIM = 256
PEER_TOPK = 16
PEER_BLOCK = 128
EPS = 1e-6
N_EVEN = (DEPTH + 1) // 2
N_ODD = DEPTH // 2

kernel_name = "hybrid_diffusion_conv_gmlp_conformer_diffattn_peer"


def rms_norm(x, g):
    xf = x.astype(jnp.float32)
    y = xf * lax.rsqrt(jnp.mean(xf * xf, axis=-1, keepdims=True) + EPS)
    return (y * g.astype(jnp.float32)).astype(x.dtype)


def modulate(h, shift, scale):
    return h * (1.0 + scale) + shift


def depthwise_conv(x, w):
    k = w.shape[0]
    return lax.conv_general_dilated(
        x, w[:, None, :].astype(x.dtype), window_strides=(1,),
        padding=((k // 2, k // 2),), dimension_numbers=('NWC', 'WIO', 'NWC'),
        feature_group_count=x.shape[-1])


def axial_rope_tables(rows):
    r = jnp.repeat(jnp.arange(rows, dtype=jnp.float32), GRID_W)
    col = jnp.tile(jnp.arange(GRID_W, dtype=jnp.float32), rows)
    n_freq = D_HEAD_DIM // 4
    inv = ROPE_THETA ** (-jnp.arange(n_freq, dtype=jnp.float32) / n_freq)
    ang = jnp.concatenate([r[:, None] * inv, col[:, None] * inv], axis=-1)
    return jnp.cos(ang), jnp.sin(ang)


def apply_rope(t, cos, sin):
    tf = t.astype(jnp.float32)
    t1, t2 = tf[..., 0::2], tf[..., 1::2]
    cs, sn = cos[None, :, None, None, :], sin[None, :, None, None, :]
    out = jnp.stack([t1 * cs - t2 * sn, t1 * sn + t2 * cs], axis=-1).reshape(t.shape)
    return out.astype(t.dtype)


def short_conv_mixer(hx, gate_c, gate_b, conv_w):
    return gate_b * depthwise_conv(gate_c * hx, conv_w)


def chunk_mlp_mixer(u, v, vnorm_g, w_s, b_s):
    bsz, L, _ = u.shape
    u = jax.nn.gelu(u)
    v = rms_norm(jax.nn.gelu(v), vnorm_g)
    v = v.reshape(bsz, L // CHUNK, CHUNK, B_GROUPS, MIX_W // B_GROUPS)
    s = jnp.einsum('gpq,bnqgc->bnpgc', w_s, v) + b_s.T[:, :, None]
    return u * s.reshape(bsz, L, MIX_W)


def even_mixer(h, w_in, w_out, conv_w, vnorm_g, w_s, b_s):
    a_h, a_c, a_b, b_u, b_v = jnp.split(h @ w_in, 5, axis=-1)
    ya = short_conv_mixer(a_h, a_c, a_b, conv_w)
    yb = chunk_mlp_mixer(b_u, b_v, vnorm_g, w_s, b_s)
    return jnp.concatenate([ya, yb], axis=-1) @ w_out


def conformer_conv(a, gate, conv_w, conv_b, norm_g):
    y = a * jax.nn.sigmoid(gate)
    y = depthwise_conv(y, conv_w) + conv_b
    return jax.nn.silu(rms_norm(y, norm_g))


def diff_attend(q, k, v, lam):
    s = jnp.einsum('bqhmd,bkhmd->bhmqk', q, k).astype(jnp.float32) * (D_HEAD_DIM ** -0.5)
    p = jax.nn.softmax(s, axis=-1)
    a = p[:, :, 0] - lam * p[:, :, 1]
    return jnp.einsum('bhqk,bkhe->bqhe', a.astype(v.dtype), v)


def diff_attend_blocked(q, k, v, lam):
    bsz, L = q.shape[:2]
    qb = q.reshape(bsz, L // CHUNK, CHUNK, *q.shape[2:]).swapaxes(0, 1)
    out = lax.map(lambda qi: diff_attend(qi, k, v, lam), qb)
    return out.swapaxes(0, 1).reshape(bsz, L, *out.shape[3:])


def odd_mixer(hx, hc, w_in, w_out, conv_w, conv_b, cnorm_g, qk_g, lam_p, subln_g,
              lam_init, cos, sin, need_ctx_out):
    bsz, L, _ = hx.shape

    def heads(t):
        return t.reshape(*t.shape[:2], D_HEADS, 2, D_HEAD_DIM)

    def values(t):
        return t.reshape(*t.shape[:2], D_HEADS, 2 * D_HEAD_DIM)

    lam_f = lam_p.astype(jnp.float32)
    lam = (jnp.exp(jnp.sum(lam_f[0] * lam_f[1])) - jnp.exp(jnp.sum(lam_f[2] * lam_f[3]))
           + lam_init)

    def finish(o):
        return (rms_norm(o, subln_g) * (1.0 - lam_init)).reshape(*o.shape[:2], MIX_W)

    ca, cg, qx, kx, vx = jnp.split(hx @ w_in, 5, axis=-1)
    qx = apply_rope(rms_norm(heads(qx), qk_g[0]), cos, sin)
    kx = apply_rope(rms_norm(heads(kx), qk_g[1]), cos, sin)
    if need_ctx_out:
        cca, ccg, qc, kc, vc = jnp.split(hc @ w_in, 5, axis=-1)
    else:
        kc, vc = jnp.split(hc @ w_in[:, 3 * MIX_W:], 2, axis=-1)
    kc = rms_norm(heads(kc), qk_g[1])
    vc = values(vc)
    k_all = jnp.concatenate([kc, kx], axis=1)
    v_all = jnp.concatenate([vc, values(vx)], axis=1)
    yx = jnp.concatenate([conformer_conv(ca, cg, conv_w, conv_b, cnorm_g),
                          finish(diff_attend_blocked(qx, k_all, v_all, lam))], axis=-1) @ w_out
    if not need_ctx_out:
        return yx, None
    qc = rms_norm(heads(qc), qk_g[0])
    yc = jnp.concatenate([conformer_conv(cca, ccg, conv_w, conv_b, cnorm_g),
                          finish(diff_attend(qc, kc, vc, lam))], axis=-1) @ w_out
    return yx, yc


def peer(h, wq, subkeys, u_tab, v_tab):
    shp = h.shape
    t = h.reshape(-1, D_MODEL)
    q = (t @ wq).reshape(-1, PEER_HEADS, 2, PEER_QDIM // 2)
    s = jnp.einsum('thpd,hpkd->thpk', q, subkeys).astype(jnp.float32)
    sv, si = lax.top_k(s, PEER_TOPK)
    cand = sv[:, :, 0, :, None] + sv[:, :, 1, None, :]
    cv, ci = lax.top_k(cand.reshape(*cand.shape[:2], PEER_TOPK * PEER_TOPK), PEER_TOPK)
    i1 = jnp.take_along_axis(si[:, :, 0], ci // PEER_TOPK, axis=-1)
    i2 = jnp.take_along_axis(si[:, :, 1], ci % PEER_TOPK, axis=-1)
    idx = i1 * PEER_KEYS + i2
    g = jax.nn.softmax(cv, axis=-1)
    nblk = t.shape[0] // PEER_BLOCK

    def block(args):
        tb, ib, gb = args
        act = jax.nn.gelu(jnp.einsum('td,thkd->thk', tb, u_tab[ib]).astype(jnp.float32))
        return jnp.einsum('thk,thkd->td', (gb * act).astype(tb.dtype), v_tab[ib])

    out = lax.map(block, (t.reshape(nblk, PEER_BLOCK, D_MODEL),
                          idx.reshape(nblk, PEER_BLOCK, PEER_HEADS, PEER_TOPK),
                          g.reshape(nblk, PEER_BLOCK, PEER_HEADS, PEER_TOPK)))
    return out.reshape(shp)


def setup_inputs(seed: int = 0) -> dict:
    key = jax.random.key(seed)
    ks = jax.random.split(key, 24)

    def nrm(k, shape, s):
        return jax.random.normal(k, shape, jnp.float32) * s

    return {
        "x": nrm(ks[0], (BATCH, SEQ, D_MODEL), 1.0),
        "c": nrm(ks[1], (BATCH, D_MODEL), 1.0),
        "ctx": nrm(ks[2], (BATCH, CTX_LEN, D_MODEL), 1.0),
        "c_ctx": nrm(ks[3], (D_MODEL,), 1.0),
        "w_ada": nrm(ks[4], (DEPTH, D_MODEL, N_ADA * D_MODEL), 0.5 * D_MODEL ** -0.5),
        "b_ada": nrm(ks[5], (DEPTH, N_ADA * D_MODEL), 0.01),
        "norm1_g": 1.0 + nrm(ks[6], (DEPTH, D_MODEL), 0.02),
        "norm2_g": 1.0 + nrm(ks[7], (DEPTH, D_MODEL), 0.02),
        "w_in": nrm(ks[8], (DEPTH, D_MODEL, IN_W), D_MODEL ** -0.5),
        "w_out": nrm(ks[9], (DEPTH, 2 * MIX_W, D_MODEL), (2 * MIX_W) ** -0.5),
        "a_conv_w": nrm(ks[10], (N_EVEN, A_CONV, MIX_W), A_CONV ** -0.5),
        "b_vnorm_g": 1.0 + nrm(ks[11], (N_EVEN, MIX_W), 0.02),
        "b_spatial_w": nrm(ks[12], (N_EVEN, B_GROUPS, CHUNK, CHUNK), 0.5 * CHUNK ** -0.5),
        "b_spatial_b": 1.0 + nrm(ks[13], (N_EVEN, B_GROUPS, CHUNK), 0.01),
        "c_conv_w": nrm(ks[14], (N_ODD, C_CONV, MIX_W), C_CONV ** -0.5),
        "c_conv_b": nrm(ks[15], (N_ODD, MIX_W), 0.01),
        "c_norm_g": 1.0 + nrm(ks[16], (N_ODD, MIX_W), 0.02),
        "d_qk_norm_g": 1.0 + nrm(ks[17], (N_ODD, 2, D_HEAD_DIM), 0.02),
        "d_lambda": nrm(ks[18], (N_ODD, 4, D_HEAD_DIM), 0.1),
        "d_subln_g": 1.0 + nrm(ks[19], (N_ODD, 2 * D_HEAD_DIM), 0.02),
        "peer_wq": nrm(ks[20], (DEPTH, D_MODEL, PEER_HEADS * PEER_QDIM), D_MODEL ** -0.5),
        "peer_subkeys": nrm(ks[21], (DEPTH, PEER_HEADS, 2, PEER_KEYS, PEER_QDIM // 2),
                            (PEER_QDIM // 2) ** -0.5),
        "peer_u": nrm(ks[22], (DEPTH, PEER_EXPERTS, D_MODEL), D_MODEL ** -0.5),
        "peer_v": nrm(ks[23], (DEPTH, PEER_EXPERTS, D_MODEL), 1.0),
    }


def reference(x, c, ctx, c_ctx, w_ada, b_ada, norm1_g, norm2_g, w_in, w_out,
              a_conv_w, b_vnorm_g, b_spatial_w, b_spatial_b,
              c_conv_w, c_conv_b, c_norm_g, d_qk_norm_g, d_lambda, d_subln_g,
              peer_wq, peer_subkeys, peer_u, peer_v):
    bsz, L, _ = x.shape
    rows = L // GRID_W
    cos, sin = axial_rope_tables(rows)
    for l in range(DEPTH):
        last = l == DEPTH - 1
        j = l // 2
        ada_x = (jax.nn.silu(c) @ w_ada[l] + b_ada[l]).reshape(bsz, 1, N_ADA, D_MODEL)
        hx = modulate(rms_norm(x, norm1_g[l]), ada_x[:, :, 0], ada_x[:, :, 1])
        ctx_read = (not last) or (l % 2 == 1)
        if ctx_read:
            ada_c = (jax.nn.silu(c_ctx) @ w_ada[l] + b_ada[l]).reshape(1, 1, N_ADA, D_MODEL)
            hc = modulate(rms_norm(ctx, norm1_g[l]), ada_c[:, :, 0], ada_c[:, :, 1])
        if l % 2 == 0:
            yx = even_mixer(hx, w_in[l], w_out[l], a_conv_w[j], b_vnorm_g[j],
                            b_spatial_w[j], b_spatial_b[j])
            yc = None if last else even_mixer(hc, w_in[l], w_out[l], a_conv_w[j], b_vnorm_g[j],
                                              b_spatial_w[j], b_spatial_b[j])
        else:
            lam_init = 0.8 - 0.6 * math.exp(-0.3 * l)
            yx, yc = odd_mixer(hx, hc, w_in[l], w_out[l], c_conv_w[j], c_conv_b[j], c_norm_g[j],
                               d_qk_norm_g[j], d_lambda[j], d_subln_g[j], lam_init, cos, sin,
                               not last)
        x = x + ada_x[:, :, 2] * yx
        h2 = modulate(rms_norm(x, norm2_g[l]), ada_x[:, :, 3], ada_x[:, :, 4])
        x = x + ada_x[:, :, 5] * peer(h2, peer_wq[l], peer_subkeys[l], peer_u[l], peer_v[l])
        if not last:
            ctx = ctx + ada_c[:, :, 2] * yc
            h2c = modulate(rms_norm(ctx, norm2_g[l]), ada_c[:, :, 3], ada_c[:, :, 4])
            ctx = ctx + ada_c[:, :, 5] * peer(h2c, peer_wq[l], peer_subkeys[l], peer_u[l], peer_v[l])
    return x
```

```cpp
#ifndef HOST_TEST
#include <hip/hip_runtime.h>
#define HD __host__ __device__ __forceinline__
#else
#define HD inline
#endif
#include <math.h>
#include <stdint.h>
#include <stddef.h>

#ifndef D_MODEL
#define D_MODEL 1024
#define BATCH 8
#define SEQ 2048
#define CTX_LEN 256
#define MIX_W 512
#define B_GROUPS 8
#define D_HEADS 4
#define D_HEAD_DIM 64
#define PEER_HEADS 8
#define PEER_KEYS 128
#define PEER_QDIM 256
#define PEER_TOPK 16
#endif
#define DEPTH 2
#define GRID_W 64
#define IN_W (5 * MIX_W)
#define A_CONV 3
#define CHUNK 128
#define C_CONV 31
#define ROPE_THETA 10000.0f
#define N_ADA 6
#define PEER_EXPERTS (PEER_KEYS * PEER_KEYS)
#define EPS 1e-6f
#define NLAT (BATCH * SEQ)
#define NCTX (BATCH * CTX_LEN)
#define NT (NLAT + NCTX)
#define LKV (CTX_LEN + SEQ)
#define PQW (PEER_HEADS * PEER_QDIM)
#define NPAIR (PEER_HEADS * PEER_TOPK)
#define BGC (MIX_W / B_GROUPS)
#define XCD_BAR_WORDS 3456
#define BAR_ALLOC_WORDS 4096
#define DBG_WORD 3584

typedef unsigned short bf16_t;
struct P {
    const float *x, *c, *ctx, *c_ctx, *w_ada, *b_ada, *norm1_g, *norm2_g, *w_in, *w_out, *a_conv_w, *b_vnorm_g, *b_spatial_w,
        *b_spatial_b, *c_conv_w, *c_conv_b, *c_norm_g, *d_qk_norm_g, *d_lambda, *d_subln_g, *peer_wq, *peer_subkeys, *peer_u, *peer_v;
    float* out;
    unsigned* bar;
    float *ada;
    float *xcur;
    bf16_t *xb;
    bf16_t *h;
    bf16_t *bufA;
    float *bufB;
    float *rstd;
    float *sv; int *si;
    int *pidx; float *pg;
    float *pw;
    bf16_t *wt_in, *wt_out, *wt_q;
    unsigned char *u8, *v8;
    float *su, *svs;
    unsigned short *pidx16;
    float *vss;
    unsigned char *hq; float *sh;
    bf16_t *wsb;
    float *rope;
    bf16_t *qp, *kp, *vt;
};
HD float bf2f(bf16_t v) { union { unsigned u; float f; } c; c.u = (unsigned)v << 16; return c.f; }
HD bf16_t f2bf(float f) { union { unsigned u; float f; } c; c.f = f; unsigned u = c.u; u += 0x7fffu + ((u >> 16) & 1u); return (bf16_t)(u >> 16); }

HD float gelu_f(float x) { return 0.5f * x * (1.0f + tanhf(0.7978845608028654f * (x + 0.044715f * x * x * x))); }
HD float sigmoid_f(float x) { return 1.0f / (1.0f + expf(-x)); }
HD float silu_f(float x) { return x * sigmoid_f(x); }
HD int tok_adarow(int t) { return t < NLAT ? t / SEQ : BATCH; }
HD int tok_pos(int t) { return t < NLAT ? t % SEQ : (t - NLAT) % CTX_LEN; }
HD int tok_len(int t) { return t < NLAT ? SEQ : CTX_LEN; }
HD const float* ada_ptr(const P& p, int l, int t, int which) { return p.ada + ((size_t)(l * (BATCH + 1) + tok_adarow(t)) * N_ADA + which) * D_MODEL; }

HD void nv_ada(long gid, const P& p, int, int) {
    const int j = (int)(gid % (N_ADA * D_MODEL)); const int r = (int)((gid / (N_ADA * D_MODEL)) % (BATCH + 1)); const int l = (int)(gid / ((long)(N_ADA * D_MODEL) * (BATCH + 1)));
    const float* cv = r < BATCH ? p.c + (size_t)r * D_MODEL : p.c_ctx;
    const float* w = p.w_ada + (size_t)l * D_MODEL * N_ADA * D_MODEL + j;
    float acc = p.b_ada[(size_t)l * N_ADA * D_MODEL + j];
    for (int i = 0; i < D_MODEL; ++i) acc += silu_f(cv[i]) * w[(size_t)i * N_ADA * D_MODEL];
    p.ada[gid] = acc;
}
HD void nv_copy_in(long gid, const P& p, int, int) {
    const long nl = (long)NLAT * D_MODEL;
    p.xcur[gid] = gid < nl ? p.x[gid] : p.ctx[gid - nl];
}
HD void nv_copy_out(long gid, const P& p, int, int) {
    float v = p.xcur[gid];
#ifdef DBG_CHECK
    const unsigned cnt = p.bar[DBG_WORD]; if (cnt) v *= 1.0f + 0.1f * (1.0f + log10f((float)cnt));
#endif
    p.out[gid] = v; }
#ifdef DBG_CHECK
HD void nv_cmp_bf16(long gid, const P& p, int, int) {
    const float a = bf2f(p.bufA[gid]), b = bf2f(((const bf16_t*)p.bufB)[gid]);
    if (!(fabsf(a - b) <= 0.05f * (fabsf(a) + fabsf(b)) + 5e-2f)) {
#ifndef HOST_TEST
        atomicAdd(&p.bar[DBG_WORD], 1u);
#endif
    }
}
#endif
HD void nv_rstd(long gid, const P& p, int, int) {
    const float* r = p.xcur + (size_t)gid * D_MODEL; float s = 0.f;
    for (int i = 0; i < D_MODEL; ++i) s += r[i] * r[i];
    p.rstd[gid] = 1.0f / sqrtf(s / D_MODEL + EPS);
}
HD void nv_mod(long gid, const P& p, int l, int which) {
    const int t = (int)(gid / D_MODEL), j = (int)(gid % D_MODEL);
    const float g = (which ? p.norm2_g : p.norm1_g)[l * D_MODEL + j];
    const float sh = ada_ptr(p, l, t, which ? 3 : 0)[j], sc = ada_ptr(p, l, t, which ? 4 : 1)[j];
    p.h[gid] = f2bf(p.xcur[gid] * p.rstd[t] * g * (1.0f + sc) + sh);
}
HD void nv_gemm_in(long gid, const P& p, int l, int) {
    const int t = (int)(gid / IN_W), n = (int)(gid % IN_W);
    const bf16_t* a = p.h + (size_t)t * D_MODEL; const float* w = p.w_in + (size_t)l * D_MODEL * IN_W + n; float acc = 0.f;
    for (int k = 0; k < D_MODEL; ++k) acc += bf2f(a[k]) * w[(size_t)k * IN_W];
    p.bufA[gid] = f2bf(acc);
}
HD void nv_gemm_out(long gid, const P& p, int l, int) {
    const int t = (int)(gid / D_MODEL), n = (int)(gid % D_MODEL);
    const bf16_t* a = p.h + (size_t)t * (2 * MIX_W); const float* w = p.w_out + (size_t)l * (2 * MIX_W) * D_MODEL + n; float acc = 0.f;
    for (int k = 0; k < 2 * MIX_W; ++k) acc += bf2f(a[k]) * w[(size_t)k * D_MODEL];
    p.xcur[gid] += ada_ptr(p, l, t, 2)[n] * acc;
}
HD void nv_gemm_q(long gid, const P& p, int l, int) {
    const int t = (int)(gid / PQW), n = (int)(gid % PQW);
    const bf16_t* a = p.h + (size_t)t * D_MODEL; const float* w = p.peer_wq + (size_t)l * D_MODEL * PQW + n; float acc = 0.f;
    for (int k = 0; k < D_MODEL; ++k) acc += bf2f(a[k]) * w[(size_t)k * PQW];
    p.bufA[gid] = f2bf(acc);
}
HD void nv_even_a(long gid, const P& p, int l, int) {
    const int t = (int)(gid / MIX_W), c = (int)(gid % MIX_W), pos = tok_pos(t), len = tok_len(t);
    const float* cw = p.a_conv_w + (size_t)(l / 2) * A_CONV * MIX_W; float acc = 0.f;
    for (int j = 0; j < A_CONV; ++j) { const int q = pos + j - A_CONV / 2; if (q < 0 || q >= len) continue;
        const bf16_t* r = p.bufA + (size_t)(t + q - pos) * IN_W; acc += cw[j * MIX_W + c] * bf2f(r[MIX_W + c]) * bf2f(r[c]); }
    p.h[(size_t)t * (2 * MIX_W) + c] = f2bf(bf2f(p.bufA[(size_t)t * IN_W + 2 * MIX_W + c]) * acc);
}
HD void nv_even_vn(long gid, const P& p, int, int) {
    const bf16_t* r = p.bufA + (size_t)gid * IN_W + 4 * MIX_W; float s = 0.f;
    for (int i = 0; i < MIX_W; ++i) { const float g = gelu_f(bf2f(r[i])); s += g * g; }
    p.rstd[gid] = 1.0f / sqrtf(s / MIX_W + EPS);
}
HD void nv_even_b(long gid, const P& p, int l, int) {
    const int t = (int)(gid / MIX_W), c = (int)(gid % MIX_W), pos = tok_pos(t), pp = pos % CHUNK, tb = t - pp, g = c / BGC;
    const float* ws = p.b_spatial_w + ((size_t)(l / 2) * B_GROUPS + g) * CHUNK * CHUNK + (size_t)pp * CHUNK;
    const float vg = p.b_vnorm_g[(l / 2) * MIX_W + c];
    float s = p.b_spatial_b[((size_t)(l / 2) * B_GROUPS + g) * CHUNK + pp];
    for (int q = 0; q < CHUNK; ++q) s += ws[q] * gelu_f(bf2f(p.bufA[(size_t)(tb + q) * IN_W + 4 * MIX_W + c])) * p.rstd[tb + q] * vg;
    p.h[(size_t)t * (2 * MIX_W) + MIX_W + c] = f2bf(gelu_f(bf2f(p.bufA[(size_t)t * IN_W + 3 * MIX_W + c])) * s);
}
HD void nv_odd_conv(long gid, const P& p, int l, int) {
    const int t = (int)(gid / MIX_W), c = (int)(gid % MIX_W), pos = tok_pos(t), len = tok_len(t);
    const float* cw = p.c_conv_w + (size_t)(l / 2) * C_CONV * MIX_W; float acc = p.c_conv_b[(l / 2) * MIX_W + c];
    for (int j = 0; j < C_CONV; ++j) { const int q = pos + j - C_CONV / 2; if (q < 0 || q >= len) continue;
        const bf16_t* r = p.bufA + (size_t)(t + q - pos) * IN_W; acc += cw[j * MIX_W + c] * bf2f(r[c]) * sigmoid_f(bf2f(r[MIX_W + c])); }
    p.bufB[gid] = acc;
}
HD void nv_odd_cnorm(long gid, const P& p, int l, int) {
    const float* r = p.bufB + (size_t)gid * MIX_W; bf16_t* o = p.h + (size_t)gid * (2 * MIX_W); float s = 0.f;
    for (int i = 0; i < MIX_W; ++i) s += r[i] * r[i];
    const float rs = 1.0f / sqrtf(s / MIX_W + EPS);
    for (int i = 0; i < MIX_W; ++i) o[i] = f2bf(silu_f(r[i] * rs * p.c_norm_g[(l / 2) * MIX_W + i]));
}
HD void nv_odd_qk(long gid, const P& p, int l, int) {
    const int m = (int)(gid % 2), hh = (int)((gid / 2) % D_HEADS), which = (int)((gid / (2 * D_HEADS)) % 2), t = (int)(gid / (4 * D_HEADS));
    bf16_t* r = p.bufA + (size_t)t * IN_W + (2 + which) * MIX_W + hh * 2 * D_HEAD_DIM + m * D_HEAD_DIM;
    const float* g = p.d_qk_norm_g + ((size_t)(l / 2) * 2 + which) * D_HEAD_DIM;
    float s = 0.f;
    for (int i = 0; i < D_HEAD_DIM; ++i) { const float v = bf2f(r[i]); s += v * v; }
    const float rs = 1.0f / sqrtf(s / D_HEAD_DIM + EPS);
    if (t < NLAT) {
        const int pos = tok_pos(t); const float row = (float)(pos / GRID_W), col = (float)(pos % GRID_W); const int nf = D_HEAD_DIM / 4;
        for (int i = 0; i < D_HEAD_DIM / 2; ++i) {
            const int fi = i < nf ? i : i - nf; const float inv = powf(ROPE_THETA, -(float)fi / (float)nf); const float ang = (i < nf ? row : col) * inv;
            const float cs = cosf(ang), sn = sinf(ang); const float t1 = bf2f(r[2 * i]) * rs * g[2 * i], t2 = bf2f(r[2 * i + 1]) * rs * g[2 * i + 1];
            r[2 * i] = f2bf(t1 * cs - t2 * sn); r[2 * i + 1] = f2bf(t1 * sn + t2 * cs); }
    } else { for (int i = 0; i < D_HEAD_DIM; ++i) r[i] = f2bf(bf2f(r[i]) * rs * g[i]); }
}
HD int kv_tok(int b, int kk) { return kk < CTX_LEN ? NLAT + b * CTX_LEN + kk : b * SEQ + (kk - CTX_LEN); }
HD void nv_attn_s(long gid, const P& p, int, int b) {
    const int kk = (int)(gid % LKV), q = (int)((gid / LKV) % SEQ), m = (int)((gid / ((long)LKV * SEQ)) % 2), hh = (int)(gid / ((long)LKV * SEQ * 2));
    const bf16_t* qr = p.bufA + (size_t)(b * SEQ + q) * IN_W + 2 * MIX_W + hh * 2 * D_HEAD_DIM + m * D_HEAD_DIM;
    const bf16_t* kr = p.bufA + (size_t)kv_tok(b, kk) * IN_W + 3 * MIX_W + hh * 2 * D_HEAD_DIM + m * D_HEAD_DIM;
    float s = 0.f;
    for (int i = 0; i < D_HEAD_DIM; ++i) s += bf2f(qr[i]) * bf2f(kr[i]);
    p.bufB[gid] = s * (1.0f / sqrtf((float)D_HEAD_DIM));
}
HD float lam_init_f(int l) { return 0.8f - 0.6f * expf(-0.3f * (float)l); }
HD float lam_val(const P& p, int l) {
    const float* lp = p.d_lambda + (size_t)(l / 2) * 4 * D_HEAD_DIM; float s0 = 0.f, s1 = 0.f;
    for (int i = 0; i < D_HEAD_DIM; ++i) { s0 += lp[i] * lp[D_HEAD_DIM + i]; s1 += lp[2 * D_HEAD_DIM + i] * lp[3 * D_HEAD_DIM + i]; }
    return expf(s0) - expf(s1) + lam_init_f(l);
}
HD void nv_attn_sm(long gid, const P& p, int l, int) {
    const int q = (int)(gid % SEQ), hh = (int)(gid / SEQ);
    float* s0 = p.bufB + ((size_t)(hh * 2 + 0) * SEQ + q) * LKV; float* s1 = p.bufB + ((size_t)(hh * 2 + 1) * SEQ + q) * LKV;
    float m0 = -1e30f, m1 = -1e30f;
    for (int k = 0; k < LKV; ++k) { m0 = fmaxf(m0, s0[k]); m1 = fmaxf(m1, s1[k]); }
    float l0 = 0.f, l1 = 0.f;
    for (int k = 0; k < LKV; ++k) { l0 += expf(s0[k] - m0); l1 += expf(s1[k] - m1); }
    const float lam = lam_val(p, l);
    for (int k = 0; k < LKV; ++k) s0[k] = expf(s0[k] - m0) / l0 - lam * expf(s1[k] - m1) / l1;
}
HD void nv_attn_pv(long gid, const P& p, int, int b) {
    const int e = (int)(gid % (2 * D_HEAD_DIM)), hh = (int)((gid / (2 * D_HEAD_DIM)) % D_HEADS), q = (int)(gid / (2 * D_HEAD_DIM * D_HEADS));
    const float* a = p.bufB + ((size_t)(hh * 2) * SEQ + q) * LKV; float acc = 0.f;
    for (int kk = 0; kk < LKV; ++kk) acc += a[kk] * bf2f(p.bufA[(size_t)kv_tok(b, kk) * IN_W + 4 * MIX_W + hh * 2 * D_HEAD_DIM + e]);
    p.bufB[((size_t)(hh * 2 + 1) * SEQ + q) * LKV + e] = acc;
}
HD void nv_attn_subln(long gid, const P& p, int l, int b) {
    const int hh = (int)(gid % D_HEADS), q = (int)(gid / D_HEADS);
    const float* r = p.bufB + ((size_t)(hh * 2 + 1) * SEQ + q) * LKV; bf16_t* o = p.h + (size_t)(b * SEQ + q) * (2 * MIX_W) + MIX_W + hh * 2 * D_HEAD_DIM; float s = 0.f;
    for (int i = 0; i < 2 * D_HEAD_DIM; ++i) s += r[i] * r[i];
    const float rs = 1.0f / sqrtf(s / (2 * D_HEAD_DIM) + EPS), li = lam_init_f(l);
    for (int i = 0; i < 2 * D_HEAD_DIM; ++i) o[i] = f2bf(r[i] * rs * p.d_subln_g[(l / 2) * 2 * D_HEAD_DIM + i] * (1.0f - li));
}
HD void nv_peer_s(long gid, const P& p, int l, int) {
    const int k = (int)(gid % PEER_KEYS), pp = (int)((gid / PEER_KEYS) % 2), hh = (int)((gid / (2 * PEER_KEYS)) % PEER_HEADS), t = (int)(gid / (2 * PEER_KEYS * PEER_HEADS));
    const bf16_t* q = p.bufA + (size_t)t * PQW + hh * PEER_QDIM + pp * (PEER_QDIM / 2);
    const float* sk = p.peer_subkeys + ((((size_t)l * PEER_HEADS + hh) * 2 + pp) * PEER_KEYS + k) * (PEER_QDIM / 2); float s = 0.f;
    for (int i = 0; i < PEER_QDIM / 2; ++i) s += bf2f(q[i]) * sk[i];
    p.bufB[gid] = s;
}
HD void nv_peer_top1(long gid, const P& p, int, int) {
    const float* s = p.bufB + (size_t)gid * PEER_KEYS; float* sv = p.sv + (size_t)gid * PEER_TOPK; int* si = p.si + (size_t)gid * PEER_TOPK;
    float pv = 3.0e38f; int pi = -1;
    for (int r = 0; r < PEER_TOPK; ++r) { float bv = -3.0e38f; int bi = -1;
        for (int k = 0; k < PEER_KEYS; ++k) { const float v = s[k]; const bool elig = v < pv || (v == pv && k > pi); if (elig && (bi < 0 || v > bv)) { bv = v; bi = k; } }
        if (bi < 0) { bi = 0; bv = 0.f; } sv[r] = bv; si[r] = bi; pv = bv; pi = bi; }
}
HD void nv_peer_top2(long gid, const P& p, int, int) {
    const float* sv0 = p.sv + (size_t)gid * 2 * PEER_TOPK; const float* sv1 = sv0 + PEER_TOPK;
    const int* si0 = p.si + (size_t)gid * 2 * PEER_TOPK; const int* si1 = si0 + PEER_TOPK;
    int* idx = p.pidx + (size_t)gid * PEER_TOPK; float* g = p.pg + (size_t)gid * PEER_TOPK;
    float pv = 3.0e38f; int pi = -1; float c0 = 0.f, sum = 0.f;
    for (int r = 0; r < PEER_TOPK; ++r) { float bv = -3.0e38f; int bi = -1;
        for (int k = 0; k < PEER_TOPK * PEER_TOPK; ++k) { const float v = sv0[k / PEER_TOPK] + sv1[k % PEER_TOPK]; const bool elig = v < pv || (v == pv && k > pi); if (elig && (bi < 0 || v > bv)) { bv = v; bi = k; } }
        if (bi < 0) { bi = 0; bv = 0.f; } idx[r] = si0[bi / PEER_TOPK] * PEER_KEYS + si1[bi % PEER_TOPK]; g[r] = bv; pv = bv; pi = bi;
        if (r == 0) c0 = bv; sum += expf(bv - c0); }
    for (int r = 0; r < PEER_TOPK; ++r) g[r] = expf(g[r] - c0) / sum;
}
HD void nv_peer_act(long gid, const P& p, int l, int) {
    const int t = (int)(gid / NPAIR); const int e = p.pidx[gid];
    const bf16_t* a = p.h + (size_t)t * D_MODEL; const float* u = p.peer_u + ((size_t)l * PEER_EXPERTS + e) * D_MODEL; float s = 0.f;
    for (int i = 0; i < D_MODEL; ++i) s += bf2f(a[i]) * u[i];
    p.pw[gid] = p.pg[gid] * gelu_f(s);
}
HD void nv_peer_out(long gid, const P& p, int l, int) {
    const int t = (int)(gid / D_MODEL), d = (int)(gid % D_MODEL);
    const int* idx = p.pidx + (size_t)t * NPAIR; const float* w = p.pw + (size_t)t * NPAIR; float acc = 0.f;
    for (int j = 0; j < NPAIR; ++j) acc += w[j] * p.peer_v[((size_t)l * PEER_EXPERTS + idx[j]) * D_MODEL + d];
    p.xcur[gid] += ada_ptr(p, l, t, 5)[d] * acc;
}

typedef void (*nv_body_t)(long, const P&, int, int);

template <class R> HD void naive_forward(R& r, const P& p) {
    r.prologue();
    r.norm_first();
    for (int l = 0; l < DEPTH; ++l) {
        const bool last = l == DEPTH - 1;
        const long nt2 = last ? NLAT : NT;
        r.gemm_in(l);
        if (l % 2 == 0) r.even_mixer(l);
        else { r.odd_conformer(l); r.odd_attention(l); }
        r.gemm_out(l, nt2);
        r.norm2(l, nt2);
        r.gemm_q(l, nt2);
        r.peer_topk(l, nt2);
        r.peer_gather(l, nt2);
    }
}
template <class R> HD void naive_prologue(R& r) { r.template run<nv_ada>((long)DEPTH * (BATCH + 1) * N_ADA * D_MODEL, 0, 0); }
template <class R> HD void naive_norm_first(R& r) {
    r.template run<nv_copy_in>((long)NT * D_MODEL, 0, 0); r.template run<nv_rstd>(NT, 0, 0); r.template run<nv_mod>((long)NT * D_MODEL, 0, 0); }
template <class R> HD void naive_even_mixer(R& r, int l) {
    r.template run<nv_even_a>((long)NT * MIX_W, l, 0); r.template run<nv_even_vn>(NT, l, 0); r.template run<nv_even_b>((long)NT * MIX_W, l, 0); }
template <class R> HD void naive_odd_conformer(R& r, int l) { r.template run<nv_odd_conv>((long)NLAT * MIX_W, l, 0); r.template run<nv_odd_cnorm>(NLAT, l, 0); }
template <class R> HD void naive_norm2(R& r, int l, long nt2) { r.template run<nv_rstd>(nt2, l, 0); r.template run<nv_mod>(nt2 * D_MODEL, l, 1); }
template <class R> HD void naive_odd_attention(R& r, int l) {
    r.template run<nv_odd_qk>((long)NT * 4 * D_HEADS, l, 0);
    for (int b = 0; b < BATCH; ++b) {
        r.template run<nv_attn_s>((long)D_HEADS * 2 * SEQ * LKV, l, b);
        r.template run<nv_attn_sm>((long)D_HEADS * SEQ, l, b);
        r.template run<nv_attn_pv>((long)SEQ * D_HEADS * 2 * D_HEAD_DIM, l, b);
        r.template run<nv_attn_subln>((long)SEQ * D_HEADS, l, b);
    }
}
template <class R> HD void naive_peer_topk(R& r, int l, long nt2) {
    r.template run<nv_peer_s>(nt2 * PEER_HEADS * 2 * PEER_KEYS, l, 0);
    r.template run<nv_peer_top1>(nt2 * PEER_HEADS * 2, l, 0);
    r.template run<nv_peer_top2>(nt2 * PEER_HEADS, l, 0);
}
template <class R> HD void naive_peer_gather(R& r, int l, long nt2) {
    r.template run<nv_peer_act>(nt2 * NPAIR, l, 0);
    r.template run<nv_peer_out>(nt2 * D_MODEL, l, 0);
    if (l == DEPTH - 1) { r.template run<nv_copy_out>((long)NLAT * D_MODEL, 0, 0); }
    else { r.template run<nv_rstd>(NT, l + 1, 0); r.template run<nv_mod>((long)NT * D_MODEL, l + 1, 0); }
}

static size_t align_up(size_t v) { return (v + 255) & ~(size_t)255; }
static size_t max_sz(size_t a, size_t b) { return a > b ? a : b; }

static size_t carve_ws(P& p, char* ws) {
    size_t off = 0;
    p.bar = (unsigned*)(ws + off); off += align_up((size_t)BAR_ALLOC_WORDS * 4);
    p.ada = (float*)(ws + off); off += align_up((size_t)DEPTH * (BATCH + 1) * N_ADA * D_MODEL * 4);
    p.rstd = (float*)(ws + off); off += align_up((size_t)NT * 4);
    p.xcur = (float*)(ws + off); off += align_up((size_t)NT * D_MODEL * 4);
    p.xb = (bf16_t*)p.xcur;
    p.h = (bf16_t*)(ws + off); off += align_up((size_t)NT * D_MODEL * 2);
    p.bufA = (bf16_t*)(ws + off); off += align_up((size_t)NT * IN_W * 2);
    p.sv = (float*)p.bufA; p.si = (int*)(p.sv + (size_t)NT * PEER_HEADS * 2 * PEER_TOPK);
    p.pidx = (int*)(ws + off); off += align_up((size_t)NT * NPAIR * 4);
    p.pg = (float*)(ws + off); off += align_up((size_t)NT * NPAIR * 4);
    p.bufB = (float*)(ws + off); off += align_up(max_sz((size_t)NT * PQW, (size_t)D_HEADS * 2 * SEQ * LKV) * 4);
    p.pw = p.bufB;
    p.qp = (bf16_t*)p.bufB; p.kp = p.qp + (size_t)BATCH * D_HEADS * 2 * SEQ * D_HEAD_DIM; p.vt = p.kp + (size_t)BATCH * D_HEADS * 2 * LKV * D_HEAD_DIM;
    p.wt_in = (bf16_t*)(ws + off); off += align_up((size_t)DEPTH * IN_W * D_MODEL * 2);
    p.wt_out = (bf16_t*)(ws + off); off += align_up((size_t)DEPTH * D_MODEL * 2 * MIX_W * 2);
    p.wt_q = (bf16_t*)(ws + off); off += align_up((size_t)DEPTH * PQW * D_MODEL * 2);
    p.u8 = (unsigned char*)(ws + off); off += align_up((size_t)DEPTH * PEER_EXPERTS * D_MODEL);
    p.v8 = (unsigned char*)(ws + off); off += align_up((size_t)DEPTH * PEER_EXPERTS * D_MODEL);
    p.su = (float*)(ws + off); off += align_up((size_t)DEPTH * PEER_EXPERTS * 4);
    p.svs = (float*)(ws + off); off += align_up((size_t)DEPTH * PEER_EXPERTS * 4);
    p.rope = (float*)(ws + off); off += align_up((size_t)SEQ * D_HEAD_DIM * 4);
    p.pidx16 = (unsigned short*)(ws + off); off += align_up((size_t)NT * NPAIR * 2);
    p.hq = (unsigned char*)(ws + off); off += align_up((size_t)NT * D_MODEL);
    p.sh = (float*)(ws + off); off += align_up((size_t)NT * 4);
    p.vss = (float*)(ws + off); off += align_up((size_t)NT * 8 * 4);
    p.wsb = (bf16_t*)(ws + off); off += align_up((size_t)((DEPTH + 1) / 2) * B_GROUPS * CHUNK * CHUNK * 2);
    return off;
}

#ifndef HOST_TEST
#define LAS __attribute__((address_space(3)))
#define NTHREADS 512
#define LDS_BYTES 147456
__device__ __forceinline__ int tid_opaque() { int t = threadIdx.x; asm volatile("" : "+v"(t)); return t; }

#define XB_TMO      128
#define XB_XCNT(j)  (256  + 64 * (j))
#define XB_XSUB(j)  (1280 + 64 * (j))
#define XB_XGEN(j)  (2304 + 64 * (j))
#define XB_TOP      3328
#define XB_TOPGEN   3392
#define XB_SPIN_CAP (1u << 24)
__device__ __forceinline__ unsigned xb_ld(unsigned* p)              { return __hip_atomic_load(p, __ATOMIC_RELAXED, __HIP_MEMORY_SCOPE_AGENT); }
__device__ __forceinline__ unsigned xb_add(unsigned* p, unsigned v) { return __hip_atomic_fetch_add(p, v, __ATOMIC_RELAXED, __HIP_MEMORY_SCOPE_AGENT); }
__device__ __forceinline__ unsigned xb_xcc_id() { return (unsigned)__builtin_amdgcn_s_getreg((3 << 11) | 20) & 0xFu; }
#define XB_SPIN(cond, bar) do { unsigned _sp = 0; while (cond) { __builtin_amdgcn_s_sleep(1); \
    if ((++_sp & 255u) == 0u) { if (xb_ld(&(bar)[XB_TMO])) break; if (_sp > XB_SPIN_CAP) { atomicAdd(&(bar)[XB_TMO], 1u); break; } } } } while (0)
struct XcdBarrier { unsigned* bar; unsigned x; volatile LAS unsigned* st; };
__device__ __forceinline__ XcdBarrier xcd_barrier_post(unsigned* bar, volatile LAS unsigned* st) {
    XcdBarrier b; b.bar = bar; b.x = xb_xcc_id(); b.st = st;
    if (threadIdx.x == 0) (void)xb_add(&bar[XB_XCNT(b.x)], 1u);
    return b;
}
__device__ __forceinline__ void xcd_barrier_complete(unsigned* bar, unsigned x, unsigned& nloc, unsigned& nx) {
    const unsigned G = gridDim.x * gridDim.y * gridDim.z;
    unsigned sum, cnt, mine, sp = 0u;
    for (;;) {
        sum = 0u; cnt = 0u; mine = 0u;
#pragma unroll
        for (unsigned j = 0; j < 16; ++j) { const unsigned c = xb_ld(&bar[XB_XCNT(j)]); sum += c; cnt += (c > 0u) ? 1u : 0u; mine = (j == x) ? c : mine; }
        if (sum == G) break;
        __builtin_amdgcn_s_sleep(1);
        if ((++sp & 255u) == 0u) { if (xb_ld(&bar[XB_TMO])) break; if (sp > XB_SPIN_CAP) { atomicAdd(&bar[XB_TMO], 1u); break; } }
    }
    nloc = mine > 0u ? mine : 1u; nx = cnt > 0u ? cnt : 1u;
}
__device__ __forceinline__ void xcd_barrier(const XcdBarrier& b) {
    asm volatile("s_waitcnt vmcnt(0)" ::: "memory");
    __syncthreads();
    if (threadIdx.x == 0) {
        unsigned* bar = b.bar;
        __builtin_amdgcn_s_waitcnt(0);
        unsigned nloc = b.st[0], nx = b.st[1];
        if (nloc == 0u) { xcd_barrier_complete(bar, b.x, nloc, nx); b.st[0] = nloc; b.st[1] = nx; }
        const unsigned old = xb_add(&bar[XB_XSUB(b.x)], 1u);
        const unsigned gen = old / nloc;
        if (old + 1u == (gen + 1u) * nloc) {
            __builtin_amdgcn_fence(__ATOMIC_RELEASE, "agent");
            asm volatile("s_waitcnt vmcnt(0)" ::: "memory");
            const unsigned og = xb_add(&bar[XB_TOP], 1u);
            const unsigned tg = og / nx;
            if (og + 1u == (tg + 1u) * nx) xb_add(&bar[XB_TOPGEN], 1u);
            else XB_SPIN(xb_ld(&bar[XB_TOPGEN]) == tg, bar);
            __builtin_amdgcn_fence(__ATOMIC_ACQUIRE, "agent");
            xb_add(&bar[XB_XGEN(b.x)], 1u);
            asm volatile("s_waitcnt vmcnt(0)" ::: "memory");
        } else {
            XB_SPIN(xb_ld(&bar[XB_XGEN(b.x)]) == gen, bar);
            __builtin_amdgcn_fence(__ATOMIC_ACQUIRE, "agent");
            asm volatile("s_waitcnt vmcnt(0)" ::: "memory");
        }
    }
    __syncthreads();
}


typedef short bf16x8 __attribute__((ext_vector_type(8)));
typedef float f32x4 __attribute__((ext_vector_type(4)));
typedef unsigned u32x4 __attribute__((ext_vector_type(4)));
typedef unsigned u32x2 __attribute__((ext_vector_type(2)));
typedef __bf16 bf16x2_t __attribute__((ext_vector_type(2)));
__device__ __forceinline__ unsigned pk_bf16(float lo, float hi) { bf16x2_t v; v[0] = (__bf16)lo; v[1] = (__bf16)hi; return __builtin_bit_cast(unsigned, v); }
__device__ __forceinline__ u32x2 quad_gather16(unsigned w0, unsigned w1, unsigned w2, unsigned w3, int lane) {
    unsigned A = (w0 & 0xffffu) | (w1 << 16), B = (w2 & 0xffffu) | (w3 << 16);
    const unsigned sel1 = (lane & 1) ? 0x03020706u : 0x05040100u;
    const unsigned tA = (unsigned)__builtin_amdgcn_update_dpp(0, (int)A, 0xB1, 0xF, 0xF, true), tB = (unsigned)__builtin_amdgcn_update_dpp(0, (int)B, 0xB1, 0xF, 0xF, true);
    A = __builtin_amdgcn_perm(tA, A, sel1); B = __builtin_amdgcn_perm(tB, B, sel1);
    const bool b1 = lane & 2;
    const unsigned keep = b1 ? B : A, send = b1 ? A : B;
    const unsigned recv = (unsigned)__builtin_amdgcn_update_dpp(0, (int)send, 0x4E, 0xF, 0xF, true);
    u32x2 o; o.x = b1 ? recv : keep; o.y = b1 ? keep : recv; return o;
}
#define WRED_DPP(v, ctrl) __int_as_float(__builtin_amdgcn_update_dpp(0, __float_as_int(v), ctrl, 0xF, 0xF, true))
__device__ __forceinline__ float wave_sum_fast(float v) {
    v += WRED_DPP(v, 0xB1); v += WRED_DPP(v, 0x4E); v += WRED_DPP(v, 0x141); v += WRED_DPP(v, 0x140);
    { auto rr = __builtin_amdgcn_permlane16_swap(__float_as_uint(v), __float_as_uint(v), false, false); v = __uint_as_float(rr[0]) + __uint_as_float(rr[1]); }
    { auto rr = __builtin_amdgcn_permlane32_swap(__float_as_uint(v), __float_as_uint(v), false, false); v = __uint_as_float(rr[0]) + __uint_as_float(rr[1]); }
    return v; }
__device__ __forceinline__ float wave_max_fast(float v) {
    v = fmaxf(v, WRED_DPP(v, 0xB1)); v = fmaxf(v, WRED_DPP(v, 0x4E)); v = fmaxf(v, WRED_DPP(v, 0x141)); v = fmaxf(v, WRED_DPP(v, 0x140));
    { auto rr = __builtin_amdgcn_permlane16_swap(__float_as_uint(v), __float_as_uint(v), false, false); v = fmaxf(__uint_as_float(rr[0]), __uint_as_float(rr[1])); }
    { auto rr = __builtin_amdgcn_permlane32_swap(__float_as_uint(v), __float_as_uint(v), false, false); v = fmaxf(__uint_as_float(rr[0]), __uint_as_float(rr[1])); }
    return v; }

__device__ __forceinline__ void transpose_item(const float* W, int K, int N, bf16_t* WT, LAS float* scr, int item, int lane) {
    const int nblk = N / 32, kb = item / nblk, nb = item % nblk, k0 = 64 * kb, n0 = 32 * nb;
    f32x4 v[8];
#pragma unroll
    for (int i = 0; i < 8; ++i) v[i] = *(const f32x4*)(W + (size_t)(k0 + 8 * i + (lane >> 3)) * N + n0 + 4 * (lane & 7));
#pragma unroll
    for (int i = 0; i < 8; ++i) { LAS float* d = scr + (8 * i + (lane >> 3)) * 33 + 4 * (lane & 7); d[0] = v[i][0]; d[1] = v[i][1]; d[2] = v[i][2]; d[3] = v[i][3]; }
    asm volatile("s_waitcnt lgkmcnt(0)" ::: "memory");
    const int c = lane & 7;
#pragma unroll
    for (int j = 0; j < 4; ++j) { const int n = (lane >> 3) + 8 * j; const LAS float* s = scr + (8 * c) * 33 + n;
        u32x4 o; o.x = pk_bf16(s[0 * 33], s[1 * 33]); o.y = pk_bf16(s[2 * 33], s[3 * 33]); o.z = pk_bf16(s[4 * 33], s[5 * 33]); o.w = pk_bf16(s[6 * 33], s[7 * 33]);
        *(u32x4*)(WT + (size_t)(n0 + n) * K + k0 + 8 * c) = o; }
    asm volatile("s_waitcnt lgkmcnt(0)" ::: "memory");
}
__device__ __forceinline__ void phase_weights(const P& p, LAS unsigned char* lds) {
    const int tid = tid_opaque(); const int lane = tid & 63, wave = tid >> 6;
    LAS float* scr = (LAS float*)(lds + 1024 + wave * 8704);
    const int gw = blockIdx.x * (NTHREADS / 64) + wave, ngw = gridDim.x * (NTHREADS / 64);
    constexpr int I_IN = (D_MODEL / 64) * (IN_W / 32), I_OUT = (2 * MIX_W / 64) * (D_MODEL / 32), I_Q = (D_MODEL / 64) * (PQW / 32);
    constexpr int PER_L = I_IN + I_OUT + I_Q;
    for (int it = gw; it < DEPTH * PER_L; it += ngw) {
        const int l = it / PER_L; int r = it % PER_L;
        if (r < I_IN) { transpose_item(p.w_in + (size_t)l * D_MODEL * IN_W, D_MODEL, IN_W, p.wt_in + (size_t)l * IN_W * D_MODEL, scr, r, lane); continue; } r -= I_IN;
        if (r < I_OUT) { transpose_item(p.w_out + (size_t)l * 2 * MIX_W * D_MODEL, 2 * MIX_W, D_MODEL, p.wt_out + (size_t)l * D_MODEL * 2 * MIX_W, scr, r, lane); continue; } r -= I_OUT;
        transpose_item(p.peer_wq + (size_t)l * D_MODEL * PQW, D_MODEL, PQW, p.wt_q + (size_t)l * PQW * D_MODEL, scr, r, lane);
    }
}

#define G_BM 256
#define G_BN 128
#define G_BK 64
#define G_STAGE (G_BM * 128 + G_BN * 128)
#define G_LDS0 1024
struct GemmDesc { const bf16_t* A; const bf16_t* Bt; int K, ntm_full, ntm_tot, ntn, part_pn_lo; };
template <class Epi> __device__ __forceinline__ void gemm_phase(LAS unsigned char* lds0, const GemmDesc g, const Epi& E) {
    LAS unsigned char* lds = lds0 + G_LDS0;
    const int tid = tid_opaque(), lane = tid & 63, wid = tid >> 6, wm = wid >> 1, wn = wid & 1, fr = lane & 15, fq = lane >> 4;
    const int nxg = (gridDim.x % 8 == 0) ? 8 : 1, xg = blockIdx.x % nxg, jb = blockIdx.x / nxg, nj = gridDim.x / nxg;
    const int a_full = g.ntm_full > xg ? (g.ntm_full - xg + nxg - 1) / nxg : 0, a_tot = g.ntm_tot > xg ? (g.ntm_tot - xg + nxg - 1) / nxg : 0;
    const int nc = g.ntn - g.part_pn_lo, n_local = a_full * g.ntn + (a_tot - a_full) * nc;
    const int K = g.K, nk = K / G_BK;
    const int srow = tid >> 3, sch = tid & 7;
    const int sw = (fr >> 1) & 7, c0 = fq ^ sw;
    const int a_rd = (wm * 64 + fr) * 128, b_rd = G_BM * 128 + (wn * 64 + fr) * 128;
    for (int u = jb; u < n_local; u += nj) {
        int a, pn;
        if (u < a_full * g.ntn) { a = u / g.ntn; pn = u % g.ntn; } else { const int u2 = u - a_full * g.ntn; a = a_full + u2 / nc; pn = g.part_pn_lo + u2 % nc; }
        const int pm = xg + nxg * a;
        const bf16_t* Ag = g.A + ((size_t)pm * G_BM + srow) * K + sch * 8;
        const bf16_t* Bg = g.Bt + ((size_t)pn * G_BN + srow) * K + sch * 8;
        f32x4 acc[4][4];
#pragma unroll
        for (int i = 0; i < 4; ++i)
#pragma unroll
            for (int j = 0; j < 4; ++j) acc[i][j] = (f32x4){0.f, 0.f, 0.f, 0.f};
        u32x4 ra[4], rb[2];
#pragma unroll
        for (int i = 0; i < 4; ++i) ra[i] = *(const u32x4*)(Ag + (size_t)(i * 64) * K);
#pragma unroll
        for (int i = 0; i < 2; ++i) rb[i] = *(const u32x4*)(Bg + (size_t)(i * 64) * K);
#pragma unroll
        for (int i = 0; i < 4; ++i) { const int row = srow + i * 64; *(LAS u32x4*)(lds + row * 128 + ((sch ^ ((row >> 1) & 7)) << 4)) = ra[i]; }
#pragma unroll
        for (int i = 0; i < 2; ++i) { const int row = srow + i * 64; *(LAS u32x4*)(lds + G_BM * 128 + row * 128 + ((sch ^ ((row >> 1) & 7)) << 4)) = rb[i]; }
        __syncthreads();
        for (int kt = 0; kt < nk; ++kt) {
            LAS unsigned char* cur = lds + (kt & 1) * G_STAGE;
            LAS unsigned char* nxt = lds + ((kt + 1) & 1) * G_STAGE;
            if (kt + 1 < nk) {
#pragma unroll
                for (int i = 0; i < 4; ++i) ra[i] = *(const u32x4*)(Ag + (size_t)(i * 64) * K + (kt + 1) * G_BK);
#pragma unroll
                for (int i = 0; i < 2; ++i) rb[i] = *(const u32x4*)(Bg + (size_t)(i * 64) * K + (kt + 1) * G_BK);
            }
#pragma unroll
            for (int kk = 0; kk < 2; ++kk) {
                bf16x8 af[4], bfr[4];
                const int co = (c0 ^ (kk * 4)) << 4;
#pragma unroll
                for (int i = 0; i < 4; ++i) af[i] = *(const LAS bf16x8*)(cur + a_rd + i * 2048 + co);
#pragma unroll
                for (int i = 0; i < 4; ++i) bfr[i] = *(const LAS bf16x8*)(cur + b_rd + i * 2048 + co);
#pragma unroll
                for (int i = 0; i < 4; ++i)
#pragma unroll
                    for (int j = 0; j < 4; ++j) acc[i][j] = __builtin_amdgcn_mfma_f32_16x16x32_bf16(bfr[j], af[i], acc[i][j], 0, 0, 0);
            }
            if (kt + 1 < nk) {
#pragma unroll
                for (int i = 0; i < 4; ++i) { const int row = srow + i * 64; *(LAS u32x4*)(nxt + row * 128 + ((sch ^ ((row >> 1) & 7)) << 4)) = ra[i]; }
#pragma unroll
                for (int i = 0; i < 2; ++i) { const int row = srow + i * 64; *(LAS u32x4*)(nxt + G_BM * 128 + row * 128 + ((sch ^ ((row >> 1) & 7)) << 4)) = rb[i]; }
            }
            __syncthreads();
        }
#pragma unroll
        for (int i = 0; i < 4; ++i)
#pragma unroll
            for (int j = 0; j < 4; ++j) E.store(pm * G_BM + wm * 64 + i * 16 + fr, pn * G_BN + wn * 64 + j * 16 + 4 * fq, acc[i][j]);
    }
}
struct EpiBf16 { bf16_t* C; int ldc;
    __device__ __forceinline__ void store(int m, int n, f32x4 v) const { uint2 o; o.x = pk_bf16(v[0], v[1]); o.y = pk_bf16(v[2], v[3]); *(uint2*)(C + (size_t)m * ldc + n) = o; } };
__device__ __forceinline__ float gelu_fast(float x) { const float u = 1.5957691216057308f * (x + 0.044715f * x * x * x); return x * __builtin_amdgcn_rcpf(1.0f + __expf(-u)); }
struct EpiBf16Gelu { bf16_t* C; int ldc; int gelu_from;
    __device__ __forceinline__ void store(int m, int n, f32x4 v) const {
        if (n >= gelu_from) { v[0] = gelu_fast(v[0]); v[1] = gelu_fast(v[1]); v[2] = gelu_fast(v[2]); v[3] = gelu_fast(v[3]); }
        uint2 o; o.x = pk_bf16(v[0], v[1]); o.y = pk_bf16(v[2], v[3]); *(uint2*)(C + (size_t)m * ldc + n) = o; } };
struct EpiRes { const float* Xlat; const float* Xctx; bf16_t* Xout; const float* ada; int l;
    __device__ __forceinline__ void store(int m, int n, f32x4 v) const {
        const f32x4 g = *(const f32x4*)(ada + ((size_t)(l * (BATCH + 1) + tok_adarow(m)) * N_ADA + 2) * D_MODEL + n);
        const float* xi = m < NLAT ? Xlat + (size_t)m * D_MODEL + n : Xctx + (size_t)(m - NLAT) * D_MODEL + n;
        const f32x4 o = *(const f32x4*)xi + g * v; u32x2 w; w.x = pk_bf16(o[0], o[1]); w.y = pk_bf16(o[2], o[3]);
        *(u32x2*)(Xout + (size_t)m * D_MODEL + n) = w; } };


template <int NI, class Epi> __device__ __forceinline__ void gemm_small(LAS unsigned char* lds0, const bf16_t* A, const bf16_t* Bt, int K, int m_base, int nM, int nN, const Epi& E) {
    constexpr int BN = 64 * NI, STAGE = 128 * 128 + BN * 128;
    LAS unsigned char* lds = lds0 + G_LDS0;
    const int tid = tid_opaque(), lane = tid & 63, wid = tid >> 6, wm = wid >> 2, wn = wid & 3, fr = lane & 15, fq = lane >> 4;
    const int nk = K / G_BK, srow = tid >> 3, sch = tid & 7;
    const int sw = (fr >> 1) & 7, c0 = fq ^ sw;
    const int a_rd = (wm * 64 + fr) * 128, b_rd = 128 * 128 + (wn * 16 * NI + fr) * 128;
    for (int u = blockIdx.x; u < nM * nN; u += gridDim.x) {
        const int pm = u / nN, pn = u % nN;
        const bf16_t* Ag = A + ((size_t)m_base + (size_t)pm * 128 + srow) * K + sch * 8;
        const bf16_t* Bg = Bt + ((size_t)pn * BN + srow) * K + sch * 8;
        f32x4 acc[4][NI];
#pragma unroll
        for (int i = 0; i < 4; ++i)
#pragma unroll
            for (int j = 0; j < NI; ++j) acc[i][j] = (f32x4){0.f, 0.f, 0.f, 0.f};
        u32x4 ra[2], rb[NI];
#pragma unroll
        for (int i = 0; i < 2; ++i) ra[i] = *(const u32x4*)(Ag + (size_t)(i * 64) * K);
#pragma unroll
        for (int i = 0; i < NI; ++i) rb[i] = *(const u32x4*)(Bg + (size_t)(i * 64) * K);
#pragma unroll
        for (int i = 0; i < 2; ++i) { const int row = srow + i * 64; *(LAS u32x4*)(lds + row * 128 + ((sch ^ ((row >> 1) & 7)) << 4)) = ra[i]; }
#pragma unroll
        for (int i = 0; i < NI; ++i) { const int row = srow + i * 64; *(LAS u32x4*)(lds + 128 * 128 + row * 128 + ((sch ^ ((row >> 1) & 7)) << 4)) = rb[i]; }
        __syncthreads();
        for (int kt = 0; kt < nk; ++kt) {
            LAS unsigned char* cur = lds + (kt & 1) * STAGE;
            LAS unsigned char* nxt = lds + ((kt + 1) & 1) * STAGE;
            const int ktn = kt + 1 < nk ? kt + 1 : kt;
#pragma unroll
            for (int i = 0; i < 2; ++i) ra[i] = *(const u32x4*)(Ag + (size_t)(i * 64) * K + ktn * G_BK);
#pragma unroll
            for (int i = 0; i < NI; ++i) rb[i] = *(const u32x4*)(Bg + (size_t)(i * 64) * K + ktn * G_BK);
#pragma unroll
            for (int kk = 0; kk < 2; ++kk) {
                bf16x8 af[4], bfr[NI];
                const int co = (c0 ^ (kk * 4)) << 4;
#pragma unroll
                for (int i = 0; i < 4; ++i) af[i] = *(const LAS bf16x8*)(cur + a_rd + i * 2048 + co);
#pragma unroll
                for (int j = 0; j < NI; ++j) bfr[j] = *(const LAS bf16x8*)(cur + b_rd + j * 2048 + co);
#pragma unroll
                for (int i = 0; i < 4; ++i)
#pragma unroll
                    for (int j = 0; j < NI; ++j) acc[i][j] = __builtin_amdgcn_mfma_f32_16x16x32_bf16(bfr[j], af[i], acc[i][j], 0, 0, 0);
            }
            if (kt + 1 < nk) {
#pragma unroll
                for (int i = 0; i < 2; ++i) { const int row = srow + i * 64; *(LAS u32x4*)(nxt + row * 128 + ((sch ^ ((row >> 1) & 7)) << 4)) = ra[i]; }
#pragma unroll
                for (int i = 0; i < NI; ++i) { const int row = srow + i * 64; *(LAS u32x4*)(nxt + 128 * 128 + row * 128 + ((sch ^ ((row >> 1) & 7)) << 4)) = rb[i]; }
            }
            __syncthreads();
        }
#pragma unroll
        for (int i = 0; i < 4; ++i)
#pragma unroll
            for (int j = 0; j < NI; ++j) E.store(m_base + pm * 128 + wm * 64 + i * 16 + fr, pn * BN + wn * 16 * NI + j * 16 + 4 * fq, acc[i][j]);
    }
}

namespace pg8 {
#define PG8_LAS __attribute__((address_space(3)))
constexpr int BM = 256, BK = 64, HALF = 128, HTB = HALF * BK * 2  , STAGE_BYTES = 8 * HTB;
__host__ __device__ __forceinline__ int lds_byte(int r, int c) { const int st = (r >> 4) * 2 + (c >> 5), rr = r & 15, cc = c & 31, ob = rr * 64 + cc * 2; return st * 1024 + (ob ^ (((ob >> 9) & 1) << 5)); }
__host__ __device__ __forceinline__ void stage_rc(int b, int& R, int& C) { const int st = b / 1024, sb = b % 1024, swz = sb ^ (((sb >> 9) & 1) << 5); R = (st >> 1) * 16 + swz / 64; C = (st & 1) * 32 + (swz % 64) / 2; }
__host__ __device__ __forceinline__ int perm32(int rho) { const int n = rho >> 4, i = rho & 15; return 8 * (i >> 2) + 4 * n + (i & 3); }
struct Unit { int pm, pn; };
struct Gemm { const bf16_t* A; const bf16_t* Bt; int M, N, K; };
struct XcdOrder {
    int nxg, xg, jb, nj, ntn, a_full, nc, part_lo, n_local;
    __device__ __forceinline__ void init(int ntm_full, int ntm_tot, int ntn_, int part_lo_) {
        nxg = (gridDim.x % 8 == 0) ? 8 : 1; xg = blockIdx.x % nxg; jb = blockIdx.x / nxg; nj = gridDim.x / nxg; ntn = ntn_; part_lo = part_lo_;
        a_full = ntm_full > xg ? (ntm_full - xg + nxg - 1) / nxg : 0; const int a_tot = ntm_tot > xg ? (ntm_tot - xg + nxg - 1) / nxg : 0;
        nc = ntn - part_lo; n_local = a_full * ntn + (a_tot - a_full) * nc; }
    __device__ __forceinline__ bool next(int i, Unit& u) const {
        const int x = jb + i * nj; if (x >= n_local) return false;
        int a, pn; if (x < a_full * ntn) { a = x / ntn; pn = x % ntn; } else { const int x2 = x - a_full * ntn; a = a_full + x2 / nc; pn = part_lo + x2 % nc; }
        u.pm = xg + nxg * a; u.pn = pn; return true; }
    __device__ __forceinline__ void a_ready(const Unit&) const {}
    __device__ __forceinline__ void done(const Unit&) const {}
};
struct EpiStoreBf16 { static constexpr bool PERM = true, AFTER_DRAIN = false; bf16_t* O; int ldc; int gelu_from;
    float* vss; int ss_from;
    __device__ __forceinline__ void operator()(const f32x4 (&acc)[2][2][4][2], const Unit& u, int wr, int wc, int fr, int fq) const {
        const int row0 = u.pm * BM + wr * 64 + fr, col0 = u.pn * BM + wc * 32 + 8 * fq; const bool ge = col0 >= gelu_from; const bool sq = u.pn * BM >= ss_from;
#pragma unroll
        for (int ai = 0; ai < 2; ++ai)
#pragma unroll
            for (int m = 0; m < 4; ++m) { bf16_t* rowp = O + (size_t)(row0 + ai * HALF + m * 16) * ldc + col0; float ss = 0.f;
#pragma unroll
                for (int bj = 0; bj < 2; ++bj) { f32x4 v0 = acc[ai][bj][m][0], v1 = acc[ai][bj][m][1];
                    if (ge) {
#pragma unroll
                        for (int k = 0; k < 4; ++k) { v0[k] = gelu_fast(v0[k]); v1[k] = gelu_fast(v1[k]); } }
                    ss += (v0[0] * v0[0] + v0[1] * v0[1]) + (v0[2] * v0[2] + v0[3] * v0[3]) + (v1[0] * v1[0] + v1[1] * v1[1]) + (v1[2] * v1[2] + v1[3] * v1[3]);
                    u32x4 w; w.x = pk_bf16(v0[0], v0[1]); w.y = pk_bf16(v0[2], v0[3]); w.z = pk_bf16(v1[0], v1[1]); w.w = pk_bf16(v1[2], v1[3]);
                    *(u32x4*)(rowp + bj * HALF) = w; }
                if (sq) {
                    { auto rr = __builtin_amdgcn_permlane16_swap(__float_as_uint(ss), __float_as_uint(ss), false, false); ss = __uint_as_float(rr[0]) + __uint_as_float(rr[1]); }
                    { auto rr = __builtin_amdgcn_permlane32_swap(__float_as_uint(ss), __float_as_uint(ss), false, false); ss = __uint_as_float(rr[0]) + __uint_as_float(rr[1]); }
                    if (fq == 0) vss[(size_t)(row0 + ai * HALF + m * 16) * 8 + (u.pn - ss_from / BM) * 4 + wc] = ss; } }
    } };
struct EpiResidual { static constexpr bool PERM = false, AFTER_DRAIN = false; const float* Xlat; const float* Xctx; const bf16_t* Xin16; bf16_t* Xout; const float* ada; int l;
    __device__ __forceinline__ void operator()(const f32x4 (&acc)[2][2][4][2], const Unit& u, int wr, int wc, int fr, int fq) const {
        const int col0 = u.pn * BM + wc * 32 + 4 * fq;
#pragma unroll
        for (int ai = 0; ai < 2; ++ai)
#pragma unroll
            for (int m = 0; m < 4; ++m) { const int r = u.pm * BM + ai * HALF + wr * 64 + m * 16 + fr;
                const float* gp = ada + ((size_t)(l * (BATCH + 1) + tok_adarow(r)) * N_ADA + 2) * D_MODEL + col0;
                const float* xi = r < NLAT ? Xlat + (size_t)r * D_MODEL + col0 : Xctx + (size_t)(r - NLAT) * D_MODEL + col0; bf16_t* xo = Xout + (size_t)r * D_MODEL + col0;
                const bf16_t* xi16 = Xin16 + (size_t)r * D_MODEL + col0;
#pragma unroll
                for (int bj = 0; bj < 2; ++bj)
#pragma unroll
                    for (int n = 0; n < 2; ++n) { const int o = bj * HALF + n * 16; f32x4 xv;
                        if (Xin16) { const u32x2 xw = *(const u32x2*)(xi16 + o); xv = (f32x4){__uint_as_float(xw.x << 16), __uint_as_float(xw.x & 0xffff0000u), __uint_as_float(xw.y << 16), __uint_as_float(xw.y & 0xffff0000u)}; }
                        else xv = *(const f32x4*)(xi + o);
                        const f32x4 ov = xv + *(const f32x4*)(gp + o) * acc[ai][bj][m][n]; u32x2 w; w.x = pk_bf16(ov[0], ov[1]); w.y = pk_bf16(ov[2], ov[3]);
                        *(u32x2*)(xo + o) = w; } }
    } };
template <class Epi, class Sched, bool ALIGN_EPI = false, bool SP2 = false>
__device__ __forceinline__ void gemm_phase(PG8_LAS unsigned char* lds, const Gemm g, const Sched& S, const Epi& E) {
    const int tid = tid_opaque(), wid = __builtin_amdgcn_readfirstlane(tid >> 6), lane = tid & 63, wr = wid >> 2, wc = wid & 3, fr = lane & 15, fq = lane >> 4;
    const int K = g.K, nt = K / BK;
    unsigned voffA[2], voffB[2];
#pragma unroll
    for (int i = 0; i < 2; ++i) { int R, C; stage_rc(tid * 16 + i * 8192, R, C); const int Rb = Epi::PERM ? ((R & ~31) + perm32(R & 31)) : R;
        voffA[i] = (unsigned)(R * K + C) * 2u; voffB[i] = (unsigned)(Rb * K + C) * 2u; }
    const size_t kstep = (size_t)(BK * 2);
    const size_t hstep = (size_t)HALF * K * 2;
    const size_t tstep = 2 * hstep;
    const unsigned ldsw = (unsigned)wid * 1024u;
    const int aoff = lds_byte(wr * 64 + fr, fq * 8), boff = lds_byte(wc * 32 + fr, fq * 8);
#define PG8_SA(b, h) (((b) * 2 + (h)) * HTB)
#define PG8_SB(b, h) ((4 + (b) * 2 + (h)) * HTB)
#define PG8_STAGE(bufoff, gbase, voff) do { _Pragma("unroll") for (int _i = 0; _i < 2; ++_i) \
        __builtin_amdgcn_global_load_lds((const unsigned*)((const char*)(gbase) + (voff)[_i]), (PG8_LAS unsigned*)(lds + (bufoff) + ldsw + _i * 8192), 16, 0, 0); } while (0)
#define PG8_LDA(dst, b, h) do { _Pragma("unroll") for (int m = 0; m < 4; ++m) _Pragma("unroll") for (int k = 0; k < 2; ++k) dst[m][k] = *(const PG8_LAS bf16x8*)(lds + PG8_SA(b, h) + aoff + m * 2048 + k * 1024); } while (0)
#define PG8_LDB(dst, b, h) do { _Pragma("unroll") for (int n = 0; n < 2; ++n) _Pragma("unroll") for (int k = 0; k < 2; ++k) dst[n][k] = *(const PG8_LAS bf16x8*)(lds + PG8_SB(b, h) + boff + n * 2048 + k * 1024); } while (0)
#define PG8_MMA(ai, bj, At, Bt) do { __builtin_amdgcn_s_setprio(1); _Pragma("unroll") for (int m = 0; m < 4; ++m) _Pragma("unroll") for (int n = 0; n < 2; ++n) _Pragma("unroll") for (int k = 0; k < 2; ++k) \
        acc[ai][bj][m][n] = __builtin_amdgcn_mfma_f32_16x16x32_bf16(Bt[n][k], At[m][k], acc[ai][bj][m][n], 0, 0, 0); __builtin_amdgcn_s_setprio(0); } while (0)
#define PG8_WAIT_V(n) asm volatile("s_waitcnt vmcnt(" #n ")" ::: "memory")
#define PG8_WAIT_L(n) asm volatile("s_waitcnt lgkmcnt(" #n ")" ::: "memory")
#define PG8_BAR __builtin_amdgcn_s_barrier()
#define PG8_SCHED __builtin_amdgcn_sched_barrier(0)
    Unit cur, nxt; int ui = 0;
    if (!S.next(0, cur)) return;
    f32x4 acc[2][2][4][2];
#pragma unroll
    for (int a = 0; a < 2; ++a)
#pragma unroll
        for (int b = 0; b < 2; ++b)
#pragma unroll
            for (int m = 0; m < 4; ++m)
#pragma unroll
                for (int n = 0; n < 2; ++n) acc[a][b][m][n] = (f32x4){0.f, 0.f, 0.f, 0.f};
    bf16x8 At[4][2], B0[2][2], B1[2][2];
    const char* cA = (const char*)g.A + (size_t)cur.pm * tstep; const char* cB = (const char*)g.Bt + (size_t)cur.pn * tstep;
    S.a_ready(cur);
    if constexpr (SP2) {
        PG8_STAGE(PG8_SB(0, 0), cB, voffB); PG8_STAGE(PG8_SB(0, 1), cB + hstep, voffB); PG8_STAGE(PG8_SA(0, 0), cA, voffA); PG8_STAGE(PG8_SA(0, 1), cA + hstep, voffA);
        if (wr == 1) PG8_BAR;
        PG8_WAIT_V(2); PG8_BAR;
        PG8_STAGE(PG8_SB(1, 0), cB + kstep, voffB); PG8_STAGE(PG8_SA(1, 0), cA + kstep, voffA); PG8_STAGE(PG8_SB(1, 1), cB + hstep + kstep, voffB);
        PG8_WAIT_V(6); PG8_BAR;
    } else {
        PG8_STAGE(PG8_SB(0, 0), cB, voffB); PG8_STAGE(PG8_SA(0, 0), cA, voffA); PG8_STAGE(PG8_SB(0, 1), cB + hstep, voffB); PG8_STAGE(PG8_SA(0, 1), cA + hstep, voffA);
        if (wr == 1) PG8_BAR;
        PG8_WAIT_V(4); PG8_BAR;
        PG8_STAGE(PG8_SB(1, 0), cB + kstep, voffB); PG8_STAGE(PG8_SA(1, 0), cA + kstep, voffA); PG8_STAGE(PG8_SB(1, 1), cB + hstep + kstep, voffB);
        PG8_WAIT_V(6); PG8_BAR;
    }
    for (;;) {
        const bool has_next = S.next(ui + 1, nxt);
        const char* nA = has_next ? (const char*)g.A + (size_t)nxt.pm * tstep : cA; const char* nB = has_next ? (const char*)g.Bt + (size_t)nxt.pn * tstep : cB;
        for (int t = 0; t < nt; t += 2) {
            const bool last = (t == nt - 2);
            const char* a1 = cA + (size_t)(t + 1) * kstep;
            const char* a2 = last ? nA : cA + (size_t)(t + 2) * kstep; const char* b2 = last ? nB : cB + (size_t)(t + 2) * kstep;
            const char* a3 = a2 + kstep; const char* b3 = b2 + kstep;
            if (last && has_next) S.a_ready(nxt);
            if constexpr (SP2) {
            PG8_LDB(B0, 0, 0); PG8_LDB(B1, 0, 1); PG8_SCHED; PG8_LDA(At, 0, 0); PG8_STAGE(PG8_SA(1, 1), a1 + hstep, voffA);
            PG8_WAIT_V(8); PG8_WAIT_L(0); PG8_BAR; PG8_MMA(0, 0, At, B0); PG8_MMA(0, 1, At, B1); PG8_BAR; PG8_SCHED;
            PG8_LDA(At, 0, 1); PG8_STAGE(PG8_SB(0, 0), b2, voffB); PG8_STAGE(PG8_SB(0, 1), b2 + hstep, voffB); PG8_STAGE(PG8_SA(0, 0), a2, voffA);
            PG8_WAIT_V(8); PG8_WAIT_L(0); PG8_BAR; PG8_MMA(1, 0, At, B0); PG8_MMA(1, 1, At, B1); PG8_BAR; PG8_SCHED;
            PG8_LDB(B0, 1, 0); PG8_LDB(B1, 1, 1); PG8_SCHED; PG8_LDA(At, 1, 0); PG8_STAGE(PG8_SA(0, 1), a2 + hstep, voffA);
            PG8_WAIT_V(8); PG8_WAIT_L(0); PG8_BAR; PG8_MMA(0, 0, At, B0); PG8_MMA(0, 1, At, B1); PG8_BAR; PG8_SCHED;
            PG8_LDA(At, 1, 1); PG8_STAGE(PG8_SB(1, 0), b3, voffB); PG8_STAGE(PG8_SB(1, 1), b3 + hstep, voffB); PG8_STAGE(PG8_SA(1, 0), a3, voffA);
            PG8_WAIT_V(8); PG8_WAIT_L(0); PG8_BAR; PG8_MMA(1, 0, At, B0); PG8_MMA(1, 1, At, B1); PG8_BAR; PG8_SCHED;
            } else {
            PG8_LDB(B0, 0, 0); PG8_SCHED; PG8_LDA(At, 0, 0); PG8_STAGE(PG8_SA(1, 1), a1 + hstep, voffA);
            PG8_WAIT_L(8); PG8_BAR; PG8_WAIT_L(0); PG8_MMA(0, 0, At, B0); PG8_BAR; PG8_SCHED;
            PG8_LDB(B1, 0, 1); PG8_STAGE(PG8_SB(0, 0), b2, voffB);
            PG8_BAR; PG8_WAIT_L(0); PG8_MMA(0, 1, At, B1); PG8_BAR;
            PG8_LDA(At, 0, 1); PG8_STAGE(PG8_SA(0, 0), a2, voffA);
            PG8_BAR; PG8_WAIT_L(0); PG8_MMA(1, 0, At, B0); PG8_BAR; PG8_SCHED;
            PG8_STAGE(PG8_SB(0, 1), b2 + hstep, voffB);
            PG8_WAIT_V(6); PG8_BAR; PG8_MMA(1, 1, At, B1); PG8_BAR;
            PG8_LDB(B0, 1, 0); PG8_SCHED; PG8_LDA(At, 1, 0); PG8_STAGE(PG8_SA(0, 1), a2 + hstep, voffA);
            PG8_WAIT_L(8); PG8_BAR; PG8_WAIT_L(0); PG8_MMA(0, 0, At, B0); PG8_BAR; PG8_SCHED;
            PG8_LDB(B1, 1, 1); PG8_STAGE(PG8_SB(1, 0), b3, voffB);
            PG8_BAR; PG8_WAIT_L(0); PG8_MMA(0, 1, At, B1); PG8_BAR;
            PG8_LDA(At, 1, 1); PG8_STAGE(PG8_SA(1, 0), a3, voffA);
            PG8_BAR; PG8_WAIT_L(0); PG8_MMA(1, 0, At, B0); PG8_BAR; PG8_SCHED;
            PG8_STAGE(PG8_SB(1, 1), b3 + hstep, voffB);
            PG8_WAIT_V(6); PG8_BAR; PG8_MMA(1, 1, At, B1); PG8_BAR;
            }
        }
        if constexpr (ALIGN_EPI) { if (wr == 0) PG8_BAR; }
        if constexpr (!Epi::AFTER_DRAIN) { E(acc, cur, wr, wc, fr, fq); S.done(cur); }
        if (!has_next) break;
#pragma unroll
        for (int a = 0; a < 2; ++a)
#pragma unroll
            for (int b = 0; b < 2; ++b)
#pragma unroll
                for (int m = 0; m < 4; ++m)
#pragma unroll
                    for (int n = 0; n < 2; ++n) acc[a][b][m][n] = (f32x4){0.f, 0.f, 0.f, 0.f};
        cur = nxt; cA = nA; cB = nB; ++ui;
        if constexpr (ALIGN_EPI) { if (wr == 1) PG8_BAR; }
    }
    PG8_WAIT_V(0);
    if constexpr (!ALIGN_EPI) { if (wr == 0) PG8_BAR; }
    PG8_BAR;
    if constexpr (Epi::AFTER_DRAIN) { E.fused(acc, cur, wr, wc, fr, fq, lds, wid, lane); S.done(cur); }
#undef PG8_SA
#undef PG8_SB
#undef PG8_STAGE
#undef PG8_LDA
#undef PG8_LDB
#undef PG8_MMA
#undef PG8_WAIT_V
#undef PG8_WAIT_L
#undef PG8_BAR
#undef PG8_SCHED
}
}

typedef float f32x2 __attribute__((ext_vector_type(2)));
typedef __bf16 bf16v2 __attribute__((ext_vector_type(2)));
typedef __bf16 bf16v8 __attribute__((ext_vector_type(8)));
typedef _Float16 f16v2 __attribute__((ext_vector_type(2)));
__device__ __forceinline__ float wave_max(float v) { return wave_max_fast(v); }
__device__ __forceinline__ float wave_sum(float v) { return wave_sum_fast(v); }
#define FP8_TOP 224.0f
__device__ __forceinline__ void convert_finish(const f32x4 (&v)[4], unsigned char* dst, size_t slice_stride, float* scale_out, int lane) {
    float m = 0.f;
#pragma unroll
    for (int i = 0; i < 4; ++i) m = fmaxf(m, fmaxf(fmaxf(fabsf(v[i][0]), fabsf(v[i][1])), fmaxf(fabsf(v[i][2]), fabsf(v[i][3]))));
    m = wave_max(m);
    const float inv = m > 0.f ? FP8_TOP / m : 0.f;
    u32x4 o;
#pragma unroll
    for (int i = 0; i < 4; ++i) { int w = 0; w = __builtin_amdgcn_cvt_pk_fp8_f32(v[i][0] * inv, v[i][1] * inv, w, false); w = __builtin_amdgcn_cvt_pk_fp8_f32(v[i][2] * inv, v[i][3] * inv, w, true); o[i] = (unsigned)w; }
#pragma unroll
    for (int i = 0; i < 4; ++i) *(unsigned*)(dst + (size_t)(2 * i + (lane >> 5)) * slice_stride + 4 * (lane & 31)) = o[i];
    if (lane == 0) *scale_out = m > 0.f ? m / FP8_TOP : 0.f;
}
__device__ __forceinline__ void phase_peer_tables(const P& p) {
    const int tid = tid_opaque(); const int lane = tid & 63, gw = blockIdx.x * (NTHREADS / 64) + (tid >> 6), ngw = gridDim.x * (NTHREADS / 64);
    const int R = DEPTH * PEER_EXPERTS;
    for (int r0 = gw; r0 < 2 * R; r0 += 4 * ngw) {
        f32x4 v[4][4];
#pragma unroll
        for (int k = 0; k < 4; ++k) { const int r = r0 + k * ngw; if (r < 2 * R) { const int tab = r / R, row = r % R; const float* src = (tab ? p.peer_v : p.peer_u) + (size_t)row * D_MODEL;
#pragma unroll
            for (int i = 0; i < 4; ++i) v[k][i] = ((const f32x4*)src)[i * 64 + lane]; } }
#pragma unroll
        for (int k = 0; k < 4; ++k) { const int r = r0 + k * ngw; if (r < 2 * R) { const int tab = r / R, row = r % R;
            convert_finish(v[k], (tab ? p.v8 : p.u8) + ((size_t)(row / PEER_EXPERTS) * 8 * PEER_EXPERTS + (row % PEER_EXPERTS)) * 128, (size_t)PEER_EXPERTS * 128, (tab ? p.svs : p.su) + row, lane); } }
    }
}
__device__ __forceinline__ float gelu_dev(float x) { return 0.5f * x * (1.0f + tanhf(0.7978845608028654f * (x + 0.044715f * x * x * x))); }
#define PG_B 16
__device__ __forceinline__ void phase_peer_gather(const P& p, int l, int ntok, bool dry = false) {
    const int tid = tid_opaque(); const int lane = tid & 63, gw = blockIdx.x * (NTHREADS / 64) + (tid >> 6), ngw = gridDim.x * (NTHREADS / 64);
    const unsigned char* U = p.u8 + (size_t)l * PEER_EXPERTS * D_MODEL + lane * 16;
    const unsigned char* V = p.v8 + (size_t)l * PEER_EXPERTS * D_MODEL + lane * 16;
    const float* su = p.su + (size_t)l * PEER_EXPERTS; const float* svs = p.svs + (size_t)l * PEER_EXPERTS;
    const bool last = l == DEPTH - 1;
    float* const xdst = dry ? p.bufB : p.xcur; float* const odst = dry ? p.bufB : p.out; bf16_t* const hdst = dry ? (bf16_t*)(p.bufB + (size_t)NT * D_MODEL) : p.h;
    for (int t = gw; t < ntok; t += ngw) {
        const int idx0 = p.pidx[(size_t)t * NPAIR + lane], idx1 = p.pidx[(size_t)t * NPAIR + 64 + lane];
        const float g0 = p.pg[(size_t)t * NPAIR + lane], g1 = p.pg[(size_t)t * NPAIR + 64 + lane];
        const float su0 = su[idx0], su1 = su[idx1], sv0 = svs[idx0], sv1 = svs[idx1];
        f32x2 hv[4][2];
#pragma unroll
        for (int i = 0; i < 4; ++i) { const uint2 w = *(const uint2*)(p.h + (size_t)t * D_MODEL + 256 * i + 4 * lane);
            hv[i][0] = (f32x2){__uint_as_float(w.x << 16), __uint_as_float(w.x & 0xffff0000u)}; hv[i][1] = (f32x2){__uint_as_float(w.y << 16), __uint_as_float(w.y & 0xffff0000u)}; }
        float dots[8];
        u32x4 buf[PG_B];
#pragma unroll 1
        for (int bt = 0; bt < 8; ++bt) {
            const int iv = bt < 4 ? idx0 : idx1;
#pragma unroll
            for (int r = 0; r < PG_B; ++r) { const int e = __builtin_amdgcn_readlane(iv, ((bt & 3) * PG_B + r)); buf[r] = *(const u32x4*)(U + (size_t)e * D_MODEL); }
            float part[PG_B];
#pragma unroll
            for (int r = 0; r < PG_B; ++r) { f32x2 a = (f32x2){0.f, 0.f}, b2 = (f32x2){0.f, 0.f};
#pragma unroll
                for (int i = 0; i < 4; ++i) { const f32x2 c0 = __builtin_amdgcn_cvt_pk_f32_fp8((int)buf[r][i], false), c1 = __builtin_amdgcn_cvt_pk_f32_fp8((int)buf[r][i], true);
                    a = c0 * hv[i][0] + a; b2 = c1 * hv[i][1] + b2; }
                part[r] = (a[0] + a[1]) + (b2[0] + b2[1]); }
            float r8[8], r4[4], r2[2], r1;
            const bool b5 = lane & 32, b4 = lane & 16, b3 = lane & 8, b2_ = lane & 4;
#pragma unroll
            for (int j = 0; j < 8; ++j) { const float keep = b5 ? part[j + 8] : part[j], send = b5 ? part[j] : part[j + 8]; r8[j] = keep + __shfl_xor(send, 32); }
#pragma unroll
            for (int j = 0; j < 4; ++j) { const float keep = b4 ? r8[j + 4] : r8[j], send = b4 ? r8[j] : r8[j + 4]; r4[j] = keep + __shfl_xor(send, 16); }
#pragma unroll
            for (int j = 0; j < 2; ++j) { const float keep = b3 ? r4[j + 2] : r4[j], send = b3 ? r4[j] : r4[j + 2]; r2[j] = keep + __shfl_xor(send, 8); }
            { const float keep = b2_ ? r2[1] : r2[0], send = b2_ ? r2[0] : r2[1]; r1 = keep + __shfl_xor(send, 4); }
            r1 += __shfl_xor(r1, 2); r1 += __shfl_xor(r1, 1);
#pragma unroll
            for (int q = 0; q < 8; ++q) if (q == bt) dots[q] = r1;
        }
        float d0, d1;
        { const int src = 4 * (lane & 15), sel = lane >> 4;
          const float t0 = __shfl(dots[0], src), t1 = __shfl(dots[1], src), t2 = __shfl(dots[2], src), t3 = __shfl(dots[3], src);
          d0 = sel == 0 ? t0 : sel == 1 ? t1 : sel == 2 ? t2 : t3;
          const float t4 = __shfl(dots[4], src), t5 = __shfl(dots[5], src), t6 = __shfl(dots[6], src), t7 = __shfl(dots[7], src);
          d1 = sel == 0 ? t4 : sel == 1 ? t5 : sel == 2 ? t6 : t7; }
        const float w0 = g0 * gelu_dev(d0 * su0) * sv0, w1 = g1 * gelu_dev(d1 * su1) * sv1;
        f32x2 acc[4][2];
#pragma unroll
        for (int i = 0; i < 4; ++i) { acc[i][0] = (f32x2){0.f, 0.f}; acc[i][1] = (f32x2){0.f, 0.f}; }
#pragma unroll 1
        for (int bt = 0; bt < 8; ++bt) {
            const int iv = bt < 4 ? idx0 : idx1; const float wv = bt < 4 ? w0 : w1;
#pragma unroll
            for (int r = 0; r < PG_B; ++r) { const int e = __builtin_amdgcn_readlane(iv, ((bt & 3) * PG_B + r)); buf[r] = *(const u32x4*)(V + (size_t)e * D_MODEL); }
#pragma unroll
            for (int r = 0; r < PG_B; ++r) { const float w = __uint_as_float(__builtin_amdgcn_readlane(__float_as_uint(wv), ((bt & 3) * PG_B + r))); const f32x2 w2 = (f32x2){w, w};
#pragma unroll
                for (int i = 0; i < 4; ++i) { const f32x2 c0 = __builtin_amdgcn_cvt_pk_f32_fp8((int)buf[r][i], false), c1 = __builtin_amdgcn_cvt_pk_f32_fp8((int)buf[r][i], true);
                    acc[i][0] = c0 * w2 + acc[i][0]; acc[i][1] = c1 * w2 + acc[i][1]; } }
        }
        const float* gate = ada_ptr(p, l, t, 5);
        f32x4 xn[4]; float ss = 0.f;
#pragma unroll
        for (int i = 0; i < 4; ++i) { const int d = 256 * i + 4 * lane; const f32x4 gt = *(const f32x4*)(gate + d); const f32x4 xo = *(const f32x4*)(p.xcur + (size_t)t * D_MODEL + d);
            xn[i] = xo + gt * (f32x4){acc[i][0][0], acc[i][0][1], acc[i][1][0], acc[i][1][1]};
            ss += (xn[i][0] * xn[i][0] + xn[i][1] * xn[i][1]) + (xn[i][2] * xn[i][2] + xn[i][3] * xn[i][3]); }
        if (last) {
#pragma unroll
            for (int i = 0; i < 4; ++i) *(f32x4*)(odst + (size_t)t * D_MODEL + 256 * i + 4 * lane) = xn[i];
        } else {
            const float rs = 1.0f / sqrtf(wave_sum(ss) * (1.0f / D_MODEL) + EPS);
            const float* sh = ada_ptr(p, l + 1, t, 0); const float* sc = ada_ptr(p, l + 1, t, 1); const float* ng = p.norm1_g + (size_t)(l + 1) * D_MODEL;
#pragma unroll
            for (int i = 0; i < 4; ++i) { const int d = 256 * i + 4 * lane; *(f32x4*)(xdst + (size_t)t * D_MODEL + d) = xn[i];
                const f32x4 g4 = *(const f32x4*)(ng + d), s4 = *(const f32x4*)(sh + d), c4 = *(const f32x4*)(sc + d);
                const f32x4 hh = xn[i] * rs * g4 * (c4 + 1.0f) + s4;
                uint2 o; o.x = pk_bf16(hh[0], hh[1]); o.y = pk_bf16(hh[2], hh[3]); *(uint2*)(hdst + (size_t)t * D_MODEL + d) = o; }
        }
    }
}


typedef float f32x16 __attribute__((ext_vector_type(16)));
__device__ __forceinline__ int mono_i(float x) { const int i = __float_as_int(x); return i ^ ((i >> 31) & 0x7fffffff); }
__device__ __forceinline__ float mono_f(int m) { return __int_as_float(m ^ ((m >> 31) & 0x7fffffff)); }
#define CE_DESC(a, b) do { const int _mx = (a) > (b) ? (a) : (b), _mn = (a) > (b) ? (b) : (a); (a) = _mx; (b) = _mn; } while (0)
__device__ __forceinline__ void sort16_desc(int (&v)[16]) {
    CE_DESC(v[0], v[13]); CE_DESC(v[1], v[12]); CE_DESC(v[2], v[15]); CE_DESC(v[3], v[14]); CE_DESC(v[4], v[8]); CE_DESC(v[5], v[6]); CE_DESC(v[7], v[11]); CE_DESC(v[9], v[10]);
    CE_DESC(v[0], v[5]); CE_DESC(v[1], v[7]); CE_DESC(v[2], v[9]); CE_DESC(v[3], v[4]); CE_DESC(v[6], v[13]); CE_DESC(v[8], v[14]); CE_DESC(v[10], v[15]); CE_DESC(v[11], v[12]);
    CE_DESC(v[0], v[1]); CE_DESC(v[2], v[3]); CE_DESC(v[4], v[5]); CE_DESC(v[6], v[8]); CE_DESC(v[7], v[9]); CE_DESC(v[10], v[11]); CE_DESC(v[12], v[13]); CE_DESC(v[14], v[15]);
    CE_DESC(v[0], v[2]); CE_DESC(v[1], v[3]); CE_DESC(v[4], v[10]); CE_DESC(v[5], v[11]); CE_DESC(v[6], v[7]); CE_DESC(v[8], v[9]); CE_DESC(v[12], v[14]); CE_DESC(v[13], v[15]);
    CE_DESC(v[1], v[2]); CE_DESC(v[3], v[12]); CE_DESC(v[4], v[6]); CE_DESC(v[5], v[7]); CE_DESC(v[8], v[10]); CE_DESC(v[9], v[11]); CE_DESC(v[13], v[14]);
    CE_DESC(v[1], v[4]); CE_DESC(v[2], v[6]); CE_DESC(v[5], v[8]); CE_DESC(v[7], v[10]); CE_DESC(v[9], v[13]); CE_DESC(v[11], v[14]);
    CE_DESC(v[2], v[4]); CE_DESC(v[3], v[6]); CE_DESC(v[9], v[12]); CE_DESC(v[11], v[13]);
    CE_DESC(v[3], v[5]); CE_DESC(v[6], v[8]); CE_DESC(v[7], v[9]); CE_DESC(v[10], v[12]);
    CE_DESC(v[3], v[4]); CE_DESC(v[5], v[6]); CE_DESC(v[7], v[8]); CE_DESC(v[9], v[10]); CE_DESC(v[11], v[12]);
    CE_DESC(v[6], v[7]); CE_DESC(v[8], v[9]);
}
template <int LOGN> __device__ __forceinline__ void bitonic_sort_desc(int (&v)[1 << LOGN]) {
#pragma unroll
    for (int lk = 1; lk <= LOGN; ++lk)
#pragma unroll
        for (int lj = lk - 1; lj >= 0; --lj)
#pragma unroll
            for (int i = 0; i < (1 << LOGN); ++i) { const int k = 1 << lk, j = 1 << lj, l = i ^ j; if (l > i) { if ((i & k) == 0) CE_DESC(v[i], v[l]); else CE_DESC(v[l], v[i]); } }
}
__device__ __forceinline__ void merge_top16(int (&a)[16], const int (&b)[16]) {
#pragma unroll
    for (int i = 0; i < 16; ++i) a[i] = a[i] > b[15 - i] ? a[i] : b[15 - i];
#pragma unroll
    for (int lj = 3; lj >= 0; --lj)
#pragma unroll
        for (int i = 0; i < 16; ++i) { const int j = 1 << lj, l = i ^ j; if (l > i) CE_DESC(a[i], a[l]); }
}
__device__ __forceinline__ void topk_half(LAS unsigned char* lds, int ph, int r31, int hi, bf16x8 (&bq)[8], const bf16_t* next_qrow, int (&L)[16]) {
    f32x16 acc[4];
#pragma unroll
    for (int mb = 0; mb < 4; ++mb)
#pragma unroll
        for (int r = 0; r < 16; ++r) acc[mb][r] = 0.f;
    bf16x8 akA[4], akB[4];
#pragma unroll
    for (int mb = 0; mb < 4; ++mb) { const int key = 32 * mb + r31; akA[mb] = *(const LAS bf16x8*)(lds + ph * 32768 + key * 256 + (((0 + hi) ^ (key & 15)) << 4)); }
#pragma unroll
    for (int s2 = 0; s2 < 4; ++s2) {
#pragma unroll
        for (int mb = 0; mb < 4; ++mb) { const int key = 32 * mb + r31; akB[mb] = *(const LAS bf16x8*)(lds + ph * 32768 + key * 256 + (((2 * (2 * s2 + 1) + hi) ^ (key & 15)) << 4)); }
        __builtin_amdgcn_sched_barrier(0);
#pragma unroll
        for (int mb = 0; mb < 4; ++mb) acc[mb] = __builtin_amdgcn_mfma_f32_32x32x16_bf16(akA[mb], bq[2 * s2], acc[mb], 0, 0, 0);
        __builtin_amdgcn_sched_barrier(0);
        if (s2 < 3) {
#pragma unroll
            for (int mb = 0; mb < 4; ++mb) { const int key = 32 * mb + r31; akA[mb] = *(const LAS bf16x8*)(lds + ph * 32768 + key * 256 + (((2 * (2 * s2 + 2) + hi) ^ (key & 15)) << 4)); } }
        __builtin_amdgcn_sched_barrier(0);
#pragma unroll
        for (int mb = 0; mb < 4; ++mb) acc[mb] = __builtin_amdgcn_mfma_f32_32x32x16_bf16(akB[mb], bq[2 * s2 + 1], acc[mb], 0, 0, 0);
        __builtin_amdgcn_sched_barrier(0);
    }
#pragma unroll
    for (int s = 0; s < 8; ++s) bq[s] = *(const bf16x8*)(next_qrow + 16 * s);
    __builtin_amdgcn_sched_barrier(0);
#pragma unroll
    for (int mb = 0; mb < 4; ++mb) { int g[16];
#pragma unroll
        for (int r = 0; r < 16; ++r) { const int key = 32 * mb + 8 * (r >> 2) + 4 * hi + (r & 3); g[r] = (mono_i(acc[mb][r]) & ~127) | key; }
        sort16_desc(g);
        if (mb == 0) {
#pragma unroll
            for (int r = 0; r < 16; ++r) L[r] = g[r];
        } else merge_top16(L, g);
        __builtin_amdgcn_sched_barrier(0); }
    int Pn[16];
#pragma unroll
    for (int r = 0; r < 16; ++r) { auto sw = __builtin_amdgcn_permlane32_swap((unsigned)L[r], (unsigned)L[r], false, false); Pn[r] = (int)(hi ? sw[0] : sw[1]); }
    merge_top16(L, Pn);
}
#define TK_LDS0 1024
__device__ __forceinline__ void phase_peer_topk(const P& p, LAS unsigned char* lds0, int l, int ntok) {
    LAS unsigned char* lds = lds0 + TK_LDS0;
    const int tid = tid_opaque(), lane = tid & 63, wave = tid >> 6, hh = blockIdx.x % PEER_HEADS, jb = blockIdx.x / PEER_HEADS, nj = gridDim.x / PEER_HEADS;
    const float* sk = p.peer_subkeys + ((size_t)l * PEER_HEADS + hh) * 2 * PEER_KEYS * (PEER_QDIM / 2);
    for (int c = tid; c < 2 * PEER_KEYS * 16; c += NTHREADS) {
        const int ch = c & 15, key = (c >> 4) & 127, ph = c >> 11;
        const f32x4 a = *(const f32x4*)(sk + (size_t)c * 8), b2 = *(const f32x4*)(sk + (size_t)c * 8 + 4);
        u32x4 o; o.x = pk_bf16(a[0], a[1]); o.y = pk_bf16(a[2], a[3]); o.z = pk_bf16(b2[0], b2[1]); o.w = pk_bf16(b2[2], b2[3]);
        *(LAS u32x4*)(lds + ph * 32768 + key * 256 + ((ch ^ (key & 15)) << 4)) = o;
    }
    __syncthreads();
    const int r31 = lane & 31, hi = lane >> 5;
    const int ntiles = ntok / 32;
    bf16x8 bq[8];
    { const int ti0 = jb * (NTHREADS / 64) + wave < ntiles ? jb * (NTHREADS / 64) + wave : 0; const bf16_t* q0 = p.bufA + (size_t)(ti0 * 32 + r31) * PQW + hh * PEER_QDIM + 8 * hi;
#pragma unroll
      for (int s = 0; s < 8; ++s) bq[s] = *(const bf16x8*)(q0 + 16 * s); }
    for (int ti = jb * (NTHREADS / 64) + wave; ti < ntiles; ti += nj * (NTHREADS / 64)) {
        const int tok = ti * 32 + r31;
        int La[16], Lb[16];
        const bf16_t* q1 = p.bufA + (size_t)tok * PQW + hh * PEER_QDIM + (PEER_QDIM / 2) + 8 * hi;
        const int tin = ti + nj * (NTHREADS / 64) < ntiles ? ti + nj * (NTHREADS / 64) : ti;
        const bf16_t* q2 = p.bufA + (size_t)(tin * 32 + r31) * PQW + hh * PEER_QDIM + 8 * hi;
        topk_half(lds, 0, r31, hi, bq, q1, La);
        __builtin_amdgcn_sched_barrier(0);
        topk_half(lds, 1, r31, hi, bq, q2, Lb);
        __builtin_amdgcn_sched_barrier(0);
#define TK_CAND(i, j) ((mono_i(mono_f(La[i] & ~127) + mono_f(Lb[j] & ~127)) & ~0x3fff) | ((La[i] & 127) << 7) | (Lb[j] & 127))
        int T[16];
        { int g[16];
          g[0] = TK_CAND(0, 0);
          g[1] = TK_CAND(0, 1);
          g[2] = TK_CAND(0, 2);
          g[3] = TK_CAND(0, 3);
          g[4] = TK_CAND(0, 4);
          g[5] = TK_CAND(0, 5);
          g[6] = TK_CAND(0, 6);
          g[7] = TK_CAND(0, 7);
          g[8] = TK_CAND(0, 8);
          g[9] = TK_CAND(0, 9);
          g[10] = TK_CAND(0, 10);
          g[11] = TK_CAND(0, 11);
          g[12] = TK_CAND(0, 12);
          g[13] = TK_CAND(0, 13);
          g[14] = TK_CAND(0, 14);
          g[15] = TK_CAND(0, 15);
          sort16_desc(g);
          _Pragma("unroll") for (int r = 0; r < 16; ++r) T[r] = g[r]; }
        { int g[16];
          g[0] = TK_CAND(1, 0);
          g[1] = TK_CAND(1, 1);
          g[2] = TK_CAND(1, 2);
          g[3] = TK_CAND(1, 3);
          g[4] = TK_CAND(1, 4);
          g[5] = TK_CAND(1, 5);
          g[6] = TK_CAND(1, 6);
          g[7] = TK_CAND(1, 7);
          g[8] = TK_CAND(2, 0);
          g[9] = TK_CAND(2, 1);
          g[10] = TK_CAND(2, 2);
          g[11] = TK_CAND(2, 3);
          g[12] = TK_CAND(2, 4);
          g[13] = TK_CAND(3, 0);
          g[14] = TK_CAND(3, 1);
          g[15] = TK_CAND(3, 2);
          sort16_desc(g);
          merge_top16(T, g); }
        { int g[16];
          g[0] = TK_CAND(3, 3);
          g[1] = TK_CAND(4, 0);
          g[2] = TK_CAND(4, 1);
          g[3] = TK_CAND(4, 2);
          g[4] = TK_CAND(5, 0);
          g[5] = TK_CAND(5, 1);
          g[6] = TK_CAND(6, 0);
          g[7] = TK_CAND(6, 1);
          g[8] = TK_CAND(7, 0);
          g[9] = TK_CAND(7, 1);
          g[10] = TK_CAND(8, 0);
          g[11] = TK_CAND(9, 0);
          g[12] = TK_CAND(10, 0);
          g[13] = TK_CAND(11, 0);
          g[14] = TK_CAND(12, 0);
          g[15] = TK_CAND(13, 0);
          sort16_desc(g);
          merge_top16(T, g); }
        { int g[16];
          g[0] = TK_CAND(14, 0);
          g[1] = TK_CAND(15, 0);
          g[2] = (int)0x80000000;
          g[3] = (int)0x80000000;
          g[4] = (int)0x80000000;
          g[5] = (int)0x80000000;
          g[6] = (int)0x80000000;
          g[7] = (int)0x80000000;
          g[8] = (int)0x80000000;
          g[9] = (int)0x80000000;
          g[10] = (int)0x80000000;
          g[11] = (int)0x80000000;
          g[12] = (int)0x80000000;
          g[13] = (int)0x80000000;
          g[14] = (int)0x80000000;
          g[15] = (int)0x80000000;
          sort16_desc(g);
          merge_top16(T, g); }
        float e[16]; float sum = 0.f; const float c0 = mono_f(T[0] & ~0x3fff);
#pragma unroll
        for (int r = 0; r < 16; ++r) { e[r] = __expf(mono_f(T[r] & ~0x3fff) - c0); sum += e[r]; }
        const float inv = 1.0f / sum;
        if (hi == 0) {
            unsigned short* oi = p.pidx16 + (size_t)tok * NPAIR + hh * PEER_TOPK; float* og = p.pg + (size_t)tok * NPAIR + hh * PEER_TOPK;
#pragma unroll
            for (int r4 = 0; r4 < 4; ++r4) {
                *(uint2*)(oi + 4 * r4) = make_uint2((unsigned)(T[4 * r4] & 0x3fff) | ((unsigned)(T[4 * r4 + 1] & 0x3fff) << 16), (unsigned)(T[4 * r4 + 2] & 0x3fff) | ((unsigned)(T[4 * r4 + 3] & 0x3fff) << 16));
                *(f32x4*)(og + 4 * r4) = (f32x4){e[4 * r4] * inv, e[4 * r4 + 1] * inv, e[4 * r4 + 2] * inv, e[4 * r4 + 3] * inv}; }
        }
    }
}


__device__ __forceinline__ void phase_rope_table(const P& p) {
    const int nf = D_HEAD_DIM / 4;
    for (int i = blockIdx.x * NTHREADS + tid_opaque(); i < SEQ * (D_HEAD_DIM / 2); i += gridDim.x * NTHREADS) {
        const int pos = i / (D_HEAD_DIM / 2), a = i % (D_HEAD_DIM / 2), fi = a % nf;
        const float inv = exp2f(-(float)fi * (13.287712379549449f / (float)nf)); const float ang = (float)(a < nf ? pos / GRID_W : pos % GRID_W) * inv;
        float sn, cs; sincosf(ang, &sn, &cs); p.rope[2 * i] = cs; p.rope[2 * i + 1] = sn; }
}
__device__ __forceinline__ void phase_attn_prep(const P& p, int l) {
    const int tid = tid_opaque(); const int lane = tid & 63, gw = blockIdx.x * (NTHREADS / 64) + (tid >> 6), ngw = gridDim.x * (NTHREADS / 64);
    {
        const float qscale = 1.4426950408889634f / sqrtf((float)D_HEAD_DIM);
        const int vsel = lane >> 2, sub = lane & 3, hh = vsel >> 2, which = (vsel >> 1) & 1, m = vsel & 1;
        const float* gq = p.d_qk_norm_g + ((size_t)(l / 2) * 2 + which) * D_HEAD_DIM + 16 * sub;
        f32x4 gqv[4];
#pragma unroll
        for (int i = 0; i < 4; ++i) gqv[i] = *(const f32x4*)(gq + 4 * i);
        const int coff = (2 + which) * MIX_W + hh * 2 * D_HEAD_DIM + m * D_HEAD_DIM + 16 * sub;
#define AP_LOAD(RAW, RP, T) { const int tt = (T) < NT ? (T) : gw; const bf16_t* s = p.bufA + (size_t)tt * IN_W + coff; RAW[0] = *(const u32x4*)s; RAW[1] = *(const u32x4*)(s + 8); \
            const int pz = tt < NLAT ? tt % SEQ : 0; const float* rr = p.rope + ((size_t)pz * (D_HEAD_DIM / 2) + 8 * sub) * 2; _Pragma("unroll") for (int i = 0; i < 4; ++i) RP[i] = *(const f32x4*)(rr + 4 * i); }
        u32x4 rawn[2]; f32x4 rpn[4];
        if (gw < NT) AP_LOAD(rawn, rpn, gw);
        for (int t = gw; t < NT; t += ngw) {
            u32x4 raw[2]; f32x4 rp[4];
#pragma unroll
            for (int i = 0; i < 2; ++i) raw[i] = rawn[i];
#pragma unroll
            for (int i = 0; i < 4; ++i) rp[i] = rpn[i];
            AP_LOAD(rawn, rpn, t + ngw);
            float ss = 0.f;
#pragma unroll
            for (int c = 0; c < 2; ++c)
#pragma unroll
                for (int k = 0; k < 4; ++k) { const float a0 = __uint_as_float(raw[c][k] << 16), b0 = __uint_as_float(raw[c][k] & 0xffff0000u); ss += a0 * a0 + b0 * b0; }
            ss += WRED_DPP(ss, 0xB1); ss += WRED_DPP(ss, 0x4E);
            const float rs = (1.0f / sqrtf(ss * (1.0f / D_HEAD_DIM) + EPS)) * (which == 0 ? qscale : 1.0f);
            const bool lat = t < NLAT; const int pos = lat ? t % SEQ : (t - NLAT) % CTX_LEN, bb = lat ? t / SEQ : (t - NLAT) / CTX_LEN;
            u32x4 o[2];
#pragma unroll
            for (int c = 0; c < 2; ++c)
#pragma unroll
                for (int k = 0; k < 4; ++k) { const int ip = 4 * c + k;
                    const float t1 = __uint_as_float(raw[c][k] << 16) * rs * gqv[ip >> 1][2 * (ip & 1)], t2 = __uint_as_float(raw[c][k] & 0xffff0000u) * rs * gqv[ip >> 1][2 * (ip & 1) + 1];
                    const float cs = lat ? rp[ip >> 1][2 * (ip & 1)] : 1.0f, sn = lat ? rp[ip >> 1][2 * (ip & 1) + 1] : 0.0f;
                    o[c][k] = pk_bf16(t1 * cs - t2 * sn, t1 * sn + t2 * cs); }
            bf16_t* dst = which == 0 ? p.qp + ((((size_t)bb * D_HEADS + hh) * 2 + m) * SEQ + pos) * D_HEAD_DIM + 16 * sub
                                     : p.kp + ((((size_t)bb * D_HEADS + hh) * 2 + m) * LKV + (lat ? CTX_LEN + pos : pos)) * D_HEAD_DIM + 16 * sub;
            if (lat || which == 1) { *(u32x4*)dst = o[0]; *(u32x4*)(dst + 8) = o[1]; }
        }
#undef AP_LOAD
    }
    const int ntile = LKV / 64;
    for (int it = gw; it < BATCH * D_HEADS * ntile; it += ngw) {
        const int kt = it % ntile, hh = (it / ntile) % D_HEADS, bb = it / (ntile * D_HEADS);
        const int row0 = kt < CTX_LEN / 64 ? NLAT + bb * CTX_LEN + kt * 64 : bb * SEQ + (kt - CTX_LEN / 64) * 64;
        const bf16_t* vbase = p.bufA + (size_t)row0 * IN_W + 4 * MIX_W + hh * 2 * D_HEAD_DIM + 2 * lane;
        unsigned w0[32], w1[32];
#pragma unroll
        for (int k2 = 0; k2 < 32; ++k2) {
            const int pp = 2 * k2, ko = (pp & 32) + 16 * ((pp >> 2) & 1) + 4 * ((pp >> 3) & 3) + (pp & 3);
            w0[k2] = *(const unsigned*)(vbase + (size_t)ko * IN_W); w1[k2] = *(const unsigned*)(vbase + (size_t)(ko + 1) * IN_W); }
        __builtin_amdgcn_sched_barrier(0);
#pragma unroll
        for (int k2 = 0; k2 < 32; ++k2) { const unsigned a = w0[k2], c = w1[k2]; w0[k2] = (a & 0xffffu) | (c << 16); w1[k2] = (a >> 16) | (c & 0xffff0000u); }
        bf16_t* dst = p.vt + (((size_t)bb * D_HEADS + hh) * 2 * D_HEAD_DIM + 2 * lane) * LKV + kt * 64;
#pragma unroll
        for (int c = 0; c < 8; ++c) { *(u32x4*)(dst + 8 * c) = (u32x4){w0[4 * c], w0[4 * c + 1], w0[4 * c + 2], w0[4 * c + 3]}; *(u32x4*)(dst + LKV + 8 * c) = (u32x4){w1[4 * c], w1[4 * c + 1], w1[4 * c + 2], w1[4 * c + 3]}; }
    }
}
__device__ __forceinline__ float quad4_max(float v) {
    auto a = __builtin_amdgcn_permlane32_swap(__float_as_uint(v), __float_as_uint(v), false, false); v = fmaxf(__uint_as_float(a[0]), __uint_as_float(a[1]));
    auto c = __builtin_amdgcn_permlane16_swap(__float_as_uint(v), __float_as_uint(v), false, false); return fmaxf(__uint_as_float(c[0]), __uint_as_float(c[1])); }
__device__ __forceinline__ float quad4_sum(float v) {
    auto a = __builtin_amdgcn_permlane32_swap(__float_as_uint(v), __float_as_uint(v), false, false); v = __uint_as_float(a[0]) + __uint_as_float(a[1]);
    auto c = __builtin_amdgcn_permlane16_swap(__float_as_uint(v), __float_as_uint(v), false, false); return __uint_as_float(c[0]) + __uint_as_float(c[1]); }
#define AT_LDS0 1024
#define AT_THR 11.5f
#define AT_KBYTES (2 * 64 * 128)
#define AT_VROW 128
#define AT_VBYTES (128 * AT_VROW)
#define AT_STAGE (AT_KBYTES + AT_VBYTES)
__device__ __forceinline__ void phase_attention(const P& p, LAS unsigned char* lds0, int l) {
    LAS unsigned char* lds = lds0 + AT_LDS0;
    const int tid = tid_opaque(), lane = tid & 63, wave = tid >> 6, fr = lane & 15, g = lane >> 4;
    const float lam = lam_val(p, l), li = lam_init_f(l);
    float gqm = 0.f, gkm = 0.f;
    { const float* gq = p.d_qk_norm_g + (size_t)(l / 2) * 2 * D_HEAD_DIM;
      for (int i = 0; i < D_HEAD_DIM; ++i) { gqm = fmaxf(gqm, fabsf(gq[i])); gkm = fmaxf(gkm, fabsf(gq[D_HEAD_DIM + i])); } }
    const float SM = sqrtf((float)D_HEAD_DIM) * gqm * gkm * 1.4426950408889634f;
    const int nxg = (gridDim.x % 8 == 0) ? 8 : 1, xg = blockIdx.x % nxg, jb = blockIdx.x / nxg, nj = gridDim.x / nxg;
    const int QB = SEQ / 128, npair = BATCH * D_HEADS, nunit = npair * QB;
    const int nloc = ((npair - xg + nxg - 1) / nxg) * QB;
    const int ntile = LKV / 64;
    for (int u = jb; u < nloc; u += nj) {
        const int pair = (u / QB) * nxg + xg, qb = u % QB, bb = pair / D_HEADS, hh = pair % D_HEADS;
        const int q0 = qb * 128 + wave * 16;
        bf16x8 bq[2][2];
#pragma unroll
        for (int m = 0; m < 2; ++m)
#pragma unroll
            for (int s = 0; s < 2; ++s) bq[m][s] = *(const bf16x8*)(p.qp + ((((size_t)bb * D_HEADS + hh) * 2 + m) * SEQ + q0 + fr) * D_HEAD_DIM + 32 * s + 8 * g);
        f32x4 O[2][8]; float lrun[2] = {0.f, 0.f};
#pragma unroll
        for (int m = 0; m < 2; ++m)
#pragma unroll
            for (int eb = 0; eb < 8; ++eb) O[m][eb] = (f32x4){0.f, 0.f, 0.f, 0.f};
        const int krow = (tid >> 3) & 63, kch = tid & 7;
        const __amdgpu_buffer_rsrc_t krs = __builtin_amdgcn_make_buffer_rsrc((void*)p.kp, 0, (int)((size_t)BATCH * D_HEADS * 2 * LKV * D_HEAD_DIM * 2), 0x00020000);
        const __amdgpu_buffer_rsrc_t vrs = __builtin_amdgcn_make_buffer_rsrc((void*)p.vt, 0, (int)((size_t)BATCH * D_HEADS * 2 * D_HEAD_DIM * LKV * 2), 0x00020000);
        const int kvo = krow * 128 + kch * 16, vvo = (tid >> 3) * (LKV * 2) + kch * 16;
        const int ks0 = (int)((((size_t)bb * D_HEADS + hh) * 2) * LKV * D_HEAD_DIM * 2), ks1 = ks0 + LKV * D_HEAD_DIM * 2;
        const int vs0 = (int)(((size_t)bb * D_HEADS + hh) * 2 * D_HEAD_DIM * LKV * 2), vs1 = vs0 + 64 * LKV * 2;
#define AT_LOADT(KT, K0, K1, V0, V1) { const int kto = (KT) * 64 * D_HEAD_DIM * 2, vto = (KT) * 64 * 2; \
            K0 = __builtin_amdgcn_raw_buffer_load_b128(krs, kvo, ks0 + kto, 0); K1 = __builtin_amdgcn_raw_buffer_load_b128(krs, kvo, ks1 + kto, 0); \
            V0 = __builtin_amdgcn_raw_buffer_load_b128(vrs, vvo, vs0 + vto, 0); V1 = __builtin_amdgcn_raw_buffer_load_b128(vrs, vvo, vs1 + vto, 0); }
        const int klds = krow * 128 + ((kch ^ ((krow >> 1) & 7)) << 4);
        const int vlds = AT_KBYTES + (tid >> 3) * AT_VROW + ((kch ^ (((tid >> 3) >> 1) & 7)) << 4);
        u32x4 rak0, rak1, rav0, rav1;
        AT_LOADT(0, rak0, rak1, rav0, rav1);
        *(LAS u32x4*)(lds + klds) = rak0; *(LAS u32x4*)(lds + 8192 + klds) = rak1; *(LAS u32x4*)(lds + vlds) = rav0; *(LAS u32x4*)(lds + vlds + 64 * AT_VROW) = rav1;
        __syncthreads();
        const unsigned koff0 = fr * 128 + ((g ^ ((fr >> 1) & 7)) << 4), koff1 = fr * 128 + (((g ^ ((fr >> 1) & 7)) ^ 4) << 4), voff0 = AT_KBYTES + fr * AT_VROW + ((g ^ ((fr >> 1) & 7)) << 4), voff1 = AT_KBYTES + fr * AT_VROW + (((g ^ ((fr >> 1) & 7)) ^ 4) << 4);
        auto tile = [&](LAS unsigned char* cur_) {
            unsigned cb = (unsigned)(size_t)cur_; asm volatile("" : "+v"(cb));
            LAS unsigned char* const ck0 = (LAS unsigned char*)(size_t)(cb + koff0); LAS unsigned char* const ck1 = (LAS unsigned char*)(size_t)(cb + koff1); LAS unsigned char* const cv0 = (LAS unsigned char*)(size_t)(cb + voff0); LAS unsigned char* const cv1 = (LAS unsigned char*)(size_t)(cb + voff1);
            bf16x8 pf[2][2]; bf16x8 kA[2][2], kB[2][2], vA[2][2], vB[2][2]; f32x4 S[4];
#define AT_LDK(dst, m, k2) { _Pragma("unroll") for (int kq = 0; kq < 2; ++kq) _Pragma("unroll") for (int s = 0; s < 2; ++s) dst[kq][s] = *(const LAS bf16x8*)((s ? ck1 : ck0) + (m) * 8192 + (2 * (k2) + kq) * 2048); }
#define AT_MMK(src, m, k2) { _Pragma("unroll") for (int kq = 0; kq < 2; ++kq) { S[2 * (k2) + kq] = (f32x4){-SM, -SM, -SM, -SM}; _Pragma("unroll") for (int s = 0; s < 2; ++s) S[2 * (k2) + kq] = __builtin_amdgcn_mfma_f32_16x16x32_bf16(src[kq][s], bq[m][s], S[2 * (k2) + kq], 0, 0, 0); } }
#define AT_LDV(dv, hf) { _Pragma("unroll") for (int e4 = 0; e4 < 2; ++e4) _Pragma("unroll") for (int ks = 0; ks < 2; ++ks) dv[e4][ks] = *(const LAS bf16x8*)((ks ? cv1 : cv0) + (16 * (2 * (hf) + e4)) * AT_VROW); }
#define AT_MMV(dv, hf) { _Pragma("unroll") for (int e4 = 0; e4 < 2; ++e4) _Pragma("unroll") for (int ks = 0; ks < 2; ++ks) { const int eb = 2 * (hf) + e4; \
                O[0][eb] = __builtin_amdgcn_mfma_f32_16x16x32_bf16(dv[e4][ks], pf[0][ks], O[0][eb], 0, 0, 0); O[1][eb] = __builtin_amdgcn_mfma_f32_16x16x32_bf16(dv[e4][ks], pf[1][ks], O[1][eb], 0, 0, 0); } }
#define AT_SOFTMAX(m) { float ls = 0.f; \
                _Pragma("unroll") for (int kb = 0; kb < 4; ++kb) _Pragma("unroll") for (int r = 0; r < 4; ++r) { const float e = __builtin_amdgcn_exp2f(S[kb][r]); S[kb][r] = e; ls += e; } \
                lrun[m] += ls; \
                _Pragma("unroll") for (int ks = 0; ks < 2; ++ks) { u32x4 w; w.x = pk_bf16(S[2 * ks][0], S[2 * ks][1]); w.y = pk_bf16(S[2 * ks][2], S[2 * ks][3]); w.z = pk_bf16(S[2 * ks + 1][0], S[2 * ks + 1][1]); w.w = pk_bf16(S[2 * ks + 1][2], S[2 * ks + 1][3]); \
                    pf[m][ks] = __builtin_bit_cast(bf16x8, w); } }
#define AT_PIN __builtin_amdgcn_sched_barrier(0)
            AT_LDK(kA, 0, 0); AT_LDK(kB, 0, 1); AT_PIN;
            AT_MMK(kA, 0, 0); AT_PIN; AT_LDK(kA, 1, 0); AT_PIN;
            AT_MMK(kB, 0, 1); AT_PIN; AT_LDK(kB, 1, 1); AT_PIN;
            AT_SOFTMAX(0); AT_PIN;
            AT_MMK(kA, 1, 0); AT_PIN; AT_LDV(vA, 0); AT_PIN;
            AT_MMK(kB, 1, 1); AT_PIN; AT_LDV(vB, 1); AT_PIN;
            AT_SOFTMAX(1); AT_PIN;
            AT_MMV(vA, 0); AT_PIN; AT_LDV(vA, 2); AT_PIN;
            AT_MMV(vB, 1); AT_PIN; AT_LDV(vB, 3); AT_PIN;
            AT_MMV(vA, 2); AT_PIN;
            AT_MMV(vB, 3);
#undef AT_LDK
#undef AT_MMK
#undef AT_LDV
#undef AT_MMV
#undef AT_SOFTMAX
#undef AT_PIN
        };
        for (int kt = 0; kt < ntile; ++kt) {
            LAS unsigned char* cur = lds + (kt & 1) * AT_STAGE; LAS unsigned char* nxt = lds + ((kt + 1) & 1) * AT_STAGE;
            { const int k1 = kt + 1 < ntile ? kt + 1 : ntile - 1; AT_LOADT(k1, rak0, rak1, rav0, rav1); }
            tile(cur);
            if (kt + 1 < ntile) { *(LAS u32x4*)(nxt + klds) = rak0; *(LAS u32x4*)(nxt + 8192 + klds) = rak1; *(LAS u32x4*)(nxt + vlds) = rav0; *(LAS u32x4*)(nxt + vlds + 64 * AT_VROW) = rav1; }
            __syncthreads();
        }
#undef AT_LOADT
        float l0 = lrun[0], l1 = lrun[1];
        l0 = quad4_sum(l0); l1 = quad4_sum(l1);
        const float i0 = 1.0f / l0, i1 = lam / l1; float ss = 0.f;
#pragma unroll
        for (int eb = 0; eb < 8; ++eb) { O[0][eb] = O[0][eb] * i0 - O[1][eb] * i1; ss += (O[0][eb][0] * O[0][eb][0] + O[0][eb][1] * O[0][eb][1]) + (O[0][eb][2] * O[0][eb][2] + O[0][eb][3] * O[0][eb][3]); }
        ss = quad4_sum(ss);
        const float rs = (1.0f / sqrtf(ss * (1.0f / (2 * D_HEAD_DIM)) + EPS)) * (1.0f - li);
        bf16_t* orow = p.h + (size_t)(bb * SEQ + q0 + fr) * (2 * MIX_W) + MIX_W + hh * 2 * D_HEAD_DIM;
        const float* sg = p.d_subln_g + (size_t)(l / 2) * 2 * D_HEAD_DIM;
#pragma unroll
        for (int eb = 0; eb < 8; ++eb) { const int e0 = 16 * eb + 4 * g; const f32x4 gg = *(const f32x4*)(sg + e0); const f32x4 y = O[0][eb] * rs * gg;
            uint2 o; o.x = pk_bf16(y[0], y[1]); o.y = pk_bf16(y[2], y[3]); *(uint2*)(orow + e0) = o; }
    }
}


__device__ __forceinline__ void phase_ada(const P& p, LAS unsigned char* lds0) {
    LAS float* sil = (LAS float*)(lds0 + 1024);
    LAS float* red = sil + (BATCH + 1) * D_MODEL;
    const int tid = tid_opaque(), kq = tid >> 4, cq = tid & 15;
    for (int i = tid; i < (BATCH + 1) * D_MODEL; i += NTHREADS) { const int r = i / D_MODEL, k = i % D_MODEL; const float v = r < BATCH ? p.c[(size_t)r * D_MODEL + k] : p.c_ctx[k]; sil[i] = v * __builtin_amdgcn_rcpf(1.0f + __expf(-v)); }
    __syncthreads();
    const int nslab = N_ADA * D_MODEL / 64;
    for (int it = blockIdx.x; it < DEPTH * nslab; it += gridDim.x) {
        const int l = it / nslab, j0 = (it % nslab) * 64 + 4 * cq;
        const float* w = p.w_ada + (size_t)l * D_MODEL * N_ADA * D_MODEL + j0;
        f32x4 acc[BATCH + 1];
#pragma unroll
        for (int r = 0; r <= BATCH; ++r) acc[r] = (f32x4){0.f, 0.f, 0.f, 0.f};
#pragma unroll
        for (int kh = 0; kh < 2; ++kh) { f32x4 wv[16];
#pragma unroll
            for (int kk = 0; kk < 16; ++kk) wv[kk] = *(const f32x4*)(w + (size_t)(kq * 32 + kh * 16 + kk) * N_ADA * D_MODEL);
#pragma unroll
            for (int kk = 0; kk < 16; ++kk) { const int k = kq * 32 + kh * 16 + kk;
#pragma unroll
                for (int r = 0; r <= BATCH; ++r) acc[r] += wv[kk] * sil[r * D_MODEL + k]; } }
#pragma unroll
        for (int r = 0; r <= BATCH; ++r) *(LAS f32x4*)(red + (kq * (BATCH + 1) + r) * 64 + 4 * cq) = acc[r];
        __syncthreads();
        for (int o = tid; o < (BATCH + 1) * 64; o += NTHREADS) { const int r = o >> 6, c = o & 63; float s = p.b_ada[(size_t)l * N_ADA * D_MODEL + (it % nslab) * 64 + c];
#pragma unroll 8
            for (int q = 0; q < 32; ++q) s += red[(q * (BATCH + 1) + r) * 64 + c];
            p.ada[((size_t)l * (BATCH + 1) + r) * N_ADA * D_MODEL + (it % nslab) * 64 + c] = s; }
        __syncthreads();
    }
}
__device__ __forceinline__ void phase_wsb(const P& p) {
    const long n4 = (long)((DEPTH + 1) / 2) * B_GROUPS * CHUNK * CHUNK / 4;
    for (long i = (long)blockIdx.x * NTHREADS + tid_opaque(); i < n4; i += (long)gridDim.x * NTHREADS) { const f32x4 v = ((const f32x4*)p.b_spatial_w)[i]; uint2 o; o.x = pk_bf16(v[0], v[1]); o.y = pk_bf16(v[2], v[3]); ((uint2*)p.wsb)[i] = o; }
}
__device__ __forceinline__ void norm_token(const P& p, int which, int t, int lane, f32x4 (&v)[4], const f32x4 (&g4)[4], const f32x4 (&s4)[4], const f32x4 (&c4)[4]) {
    float ss = 0.f;
#pragma unroll
    for (int i = 0; i < 4; ++i) ss += (v[i][0] * v[i][0] + v[i][1] * v[i][1]) + (v[i][2] * v[i][2] + v[i][3] * v[i][3]);
    const float rs = 1.0f / sqrtf(wave_sum_fast(ss) * (1.0f / D_MODEL) + EPS);
    float hm = 0.f;
#pragma unroll
    for (int i = 0; i < 4; ++i) { const int d = 256 * i + 4 * lane;
        const f32x4 hh = v[i] * rs * g4[i] * (c4[i] + 1.0f) + s4[i]; uint2 o; o.x = pk_bf16(hh[0], hh[1]); o.y = pk_bf16(hh[2], hh[3]); *(uint2*)(p.h + (size_t)t * D_MODEL + d) = o;
        v[i] = hh; hm = fmaxf(hm, fmaxf(fmaxf(fabsf(hh[0]), fabsf(hh[1])), fmaxf(fabsf(hh[2]), fabsf(hh[3])))); }
    if (which) {
        hm = wave_max_fast(hm); const float inv = hm > 0.f ? 119.0f / hm : 0.f;
        unsigned wa[4], wb[4];
#pragma unroll
        for (int i = 0; i < 4; ++i) { wa[i] = 0u; wb[i] = 0u;
#pragma unroll
            for (int j = 0; j < 4; ++j) { const int q = (int)rintf(v[i][j] * inv); wb[i] |= (unsigned)(q & 15) << (4 * j); wa[i] |= (unsigned)(((q + 8) >> 4) & 15) << (4 * j); } }
        *(u32x2*)(p.hq + (size_t)t * D_MODEL + (lane & 3) * 128 + 8 * (lane >> 2)) = quad_gather16(wa[0], wa[1], wa[2], wa[3], lane);
        *(u32x2*)(p.hq + (size_t)t * D_MODEL + 512 + (lane & 3) * 128 + 8 * (lane >> 2)) = quad_gather16(wb[0], wb[1], wb[2], wb[3], lane);
        if (lane == 0) p.sh[t] = hm * (1.0f / 119.0f);
    }
}
__device__ __forceinline__ void phase_norm(const P& p, int l, int which, int ntok, bool from_input) {
    const int tid = tid_opaque(); const int lane = tid & 63, gw = blockIdx.x * (NTHREADS / 64) + (tid >> 6), ngw = gridDim.x * (NTHREADS / 64);
    const float* ng = (which ? p.norm2_g : p.norm1_g) + (size_t)l * D_MODEL;
    f32x4 g4[4];
#pragma unroll
    for (int i = 0; i < 4; ++i) g4[i] = *(const f32x4*)(ng + 256 * i + 4 * lane);
#define NORM_XLOAD(V, T) { const int tt = (T); \
        const float* xr = tt < NLAT ? p.x + (size_t)tt * D_MODEL : p.ctx + (size_t)(tt - NLAT) * D_MODEL; const bf16_t* xr16 = p.xb + (size_t)tt * D_MODEL; \
        _Pragma("unroll") for (int i = 0; i < 4; ++i) { \
            if (from_input) V[i] = *(const f32x4*)(xr + 256 * i + 4 * lane); \
            else { const u32x2 xw = *(const u32x2*)(xr16 + 256 * i + 4 * lane); V[i] = (f32x4){__uint_as_float(xw.x << 16), __uint_as_float(xw.x & 0xffff0000u), __uint_as_float(xw.y << 16), __uint_as_float(xw.y & 0xffff0000u)}; } } }
#define NORM_ADA(S4, C4, T) { const float* shp = ada_ptr(p, l, (T), which ? 3 : 0); const float* scp = ada_ptr(p, l, (T), which ? 4 : 1); \
        _Pragma("unroll") for (int i = 0; i < 4; ++i) { S4[i] = *(const f32x4*)(shp + 256 * i + 4 * lane); C4[i] = *(const f32x4*)(scp + 256 * i + 4 * lane); } }
    const int wpb = ngw / BATCH, b = gw % BATCH, j0 = gw / BATCH;
    if (j0 < wpb) {
        f32x4 s4[4], c4[4], vn[4];
        NORM_ADA(s4, c4, b * SEQ);
        NORM_XLOAD(vn, b * SEQ + j0);
        for (int j = j0; j < SEQ; j += wpb) {
            f32x4 v[4];
#pragma unroll
            for (int i = 0; i < 4; ++i) v[i] = vn[i];
            { const int jn = j + wpb < SEQ ? j + wpb : j0; NORM_XLOAD(vn, b * SEQ + jn); }
            norm_token(p, which, b * SEQ + j, lane, v, g4, s4, c4);
        }
    }
    if (ntok > NLAT && gw < ntok - NLAT) {
        f32x4 s4[4], c4[4];
        NORM_ADA(s4, c4, NLAT);
        for (int t = NLAT + gw; t < ntok; t += ngw) { f32x4 v[4]; NORM_XLOAD(v, t); norm_token(p, which, t, lane, v, g4, s4, c4); }
    }
#undef NORM_XLOAD
#undef NORM_ADA
}
__device__ __forceinline__ float bflo(unsigned w) { return __uint_as_float(w << 16); }
__device__ __forceinline__ float bfhi(unsigned w) { return __uint_as_float(w & 0xffff0000u); }
#define EM_LDS0 1024
#define EM_VROW 272
__device__ __forceinline__ void phase_even_mixer(const P& p, LAS unsigned char* lds0, int l) {
    LAS float* rstd = (LAS float*)(lds0 + EM_LDS0);
    LAS unsigned char* vt = lds0 + EM_LDS0 + 512;
    const int tid = tid_opaque(), lane = tid & 63, wave = tid >> 6, fr = lane & 15, g4 = lane >> 4;
    const int j = l / 2; const int nchunk = NT / CHUNK;
    for (int it = blockIdx.x; it < nchunk * B_GROUPS; it += gridDim.x) {
        const int g = it % B_GROUPS, t0 = (it / B_GROUPS) * CHUNK;
        const int q = tid >> 2, qt = tid & 3;
        const bf16_t* prow = p.bufA + (size_t)(t0 + q) * IN_W;
        { const f32x2 pv = *(const f32x2*)(p.vss + (size_t)(t0 + q) * 8 + 2 * qt); float ss = pv[0] + pv[1];
          ss += WRED_DPP(ss, 0xB1); ss += WRED_DPP(ss, 0x4E);
          if (qt == 0) rstd[q] = 1.0f / sqrtf(ss * (1.0f / MIX_W) + EPS); }
        __syncthreads();
        { const float rq = rstd[q];
#pragma unroll
          for (int h2 = 0; h2 < 2; ++h2) { const u32x4 w = *(const u32x4*)(prow + 4 * MIX_W + 64 * g + 16 * qt + 8 * h2);
#pragma unroll
              for (int k = 0; k < 4; ++k) { const int c = 16 * qt + 8 * h2 + 2 * k;
                  *(LAS bf16_t*)(vt + c * EM_VROW + q * 2) = (bf16_t)(pk_bf16(bflo(w[k]) * rq, 0.f) & 0xffffu);
                  *(LAS bf16_t*)(vt + (c + 1) * EM_VROW + q * 2) = (bf16_t)(pk_bf16(bfhi(w[k]) * rq, 0.f) & 0xffffu); } } }
        { const int t = t0 + q, pos = tok_pos(t), len = tok_len(t), cb = 64 * g + 16 * qt;
          const float* cw = p.a_conv_w + (size_t)j * A_CONV * MIX_W + cb;
#pragma unroll
          for (int h2 = 0; h2 < 2; ++h2) { float acc[8];
#pragma unroll
              for (int k = 0; k < 8; ++k) acc[k] = 0.f;
#pragma unroll
              for (int jj = 0; jj < A_CONV; ++jj) { const int qq = pos + jj - A_CONV / 2;
                  if (qq >= 0 && qq < len) { const bf16_t* rr = p.bufA + (size_t)(t + jj - A_CONV / 2) * IN_W + cb + 8 * h2;
                      const u32x4 ah = *(const u32x4*)rr, ac = *(const u32x4*)(rr + MIX_W);
                      const f32x4 w0 = *(const f32x4*)(cw + jj * MIX_W + 8 * h2), w1 = *(const f32x4*)(cw + jj * MIX_W + 8 * h2 + 4);
#pragma unroll
                      for (int k = 0; k < 4; ++k) { acc[2 * k] += (k < 2 ? w0[2 * k] : w1[2 * k - 4]) * bflo(ah[k]) * bflo(ac[k]); acc[2 * k + 1] += (k < 2 ? w0[2 * k + 1] : w1[2 * k - 3]) * bfhi(ah[k]) * bfhi(ac[k]); } } }
              const u32x4 ab = *(const u32x4*)(prow + 2 * MIX_W + cb + 8 * h2); u32x4 o;
#pragma unroll
              for (int k = 0; k < 4; ++k) o[k] = pk_bf16(bflo(ab[k]) * acc[2 * k], bfhi(ab[k]) * acc[2 * k + 1]);
              *(u32x4*)(p.h + (size_t)t * (2 * MIX_W) + cb + 8 * h2) = o; } }
        __syncthreads();
        { const int pp = 16 * wave + fr; const bf16_t* wrow = p.wsb + (((size_t)j * B_GROUPS + g) * CHUNK + pp) * CHUNK + 8 * g4;
          bf16x8 bw[4];
#pragma unroll
          for (int s = 0; s < 4; ++s) bw[s] = *(const bf16x8*)(wrow + 32 * s);
          f32x4 acc[4];
#pragma unroll
          for (int cb = 0; cb < 4; ++cb) { acc[cb] = (f32x4){0.f, 0.f, 0.f, 0.f};
#pragma unroll
              for (int s = 0; s < 4; ++s) { const bf16x8 av = *(const LAS bf16x8*)(vt + (16 * cb + fr) * EM_VROW + (4 * s + g4) * 16); acc[cb] = __builtin_amdgcn_mfma_f32_16x16x32_bf16(av, bw[s], acc[cb], 0, 0, 0); } }
          const int t = t0 + pp; const float bs = p.b_spatial_b[((size_t)j * B_GROUPS + g) * CHUNK + pp];
#pragma unroll
          for (int cb = 0; cb < 4; ++cb) { const int c = 64 * g + 16 * cb + 4 * g4; const f32x4 vg = *(const f32x4*)(p.b_vnorm_g + (size_t)j * MIX_W + c);
              const uint2 gu = *(const uint2*)(p.bufA + (size_t)t * IN_W + 3 * MIX_W + c); const f32x4 s4 = acc[cb] * vg + bs;
              uint2 o; o.x = pk_bf16(bflo(gu.x) * s4[0], bfhi(gu.x) * s4[1]); o.y = pk_bf16(bflo(gu.y) * s4[2], bfhi(gu.y) * s4[3]);
              *(uint2*)(p.h + (size_t)t * (2 * MIX_W) + MIX_W + c) = o; } }
        __syncthreads();
    }
}
#define CF_T 32
#define CF_ROWS (CF_T + C_CONV - 1)
__device__ __forceinline__ void phase_conformer(const P& p, LAS unsigned char* lds0, int l) {
    LAS bf16_t* ys = (LAS bf16_t*)(lds0 + 1024);
    LAS float* part = (LAS float*)(lds0 + 1024 + CF_ROWS * MIX_W * 2);
    const int tid = tid_opaque(), lane = tid & 63, wave = tid >> 6, j = l / 2;
    float wc[C_CONV];
#pragma unroll
    for (int k = 0; k < C_CONV; ++k) wc[k] = p.c_conv_w[((size_t)j * C_CONV + k) * MIX_W + tid];
    const float bias = p.c_conv_b[(size_t)j * MIX_W + tid], gn = p.c_norm_g[(size_t)j * MIX_W + tid];
    for (int it = blockIdx.x; it < NLAT / CF_T; it += gridDim.x) {
        const int t0 = it * CF_T, pos0 = t0 % SEQ;
        for (int c = tid; c < CF_ROWS * (MIX_W / 8); c += NTHREADS) { const int row = c / (MIX_W / 8), ch = c % (MIX_W / 8), pos = pos0 + row - C_CONV / 2;
            u32x4 o = (u32x4){0u, 0u, 0u, 0u};
            if (pos >= 0 && pos < SEQ) { const bf16_t* rr = p.bufA + (size_t)(t0 + row - C_CONV / 2) * IN_W + 8 * ch; const u32x4 a = *(const u32x4*)rr, gte = *(const u32x4*)(rr + MIX_W);
#pragma unroll
                for (int k = 0; k < 4; ++k) o[k] = pk_bf16(bflo(a[k]) * __builtin_amdgcn_rcpf(1.0f + __expf(-bflo(gte[k]))), bfhi(a[k]) * __builtin_amdgcn_rcpf(1.0f + __expf(-bfhi(gte[k])))); }
            *(LAS u32x4*)((LAS unsigned char*)ys + row * (MIX_W * 2) + ch * 16) = o; }
        __syncthreads();
        float yv[CF_ROWS];
#pragma unroll
        for (int r = 0; r < CF_ROWS; ++r) yv[r] = __uint_as_float((unsigned)ys[r * MIX_W + tid] << 16);
        float outv[CF_T];
#pragma unroll
        for (int t = 0; t < CF_T; ++t) { float a = bias;
#pragma unroll
            for (int k = 0; k < C_CONV; ++k) a += wc[k] * yv[t + k];
            outv[t] = a; }
        { static_assert(CF_T == 32, "transposed reduction below is written for 32 tokens");
          float a16[16], a8[8], a4[4], a2[2];
#pragma unroll
          for (int i = 0; i < 16; ++i) { auto rr = __builtin_amdgcn_permlane32_swap(__float_as_uint(outv[i] * outv[i]), __float_as_uint(outv[i + 16] * outv[i + 16]), false, false); a16[i] = __uint_as_float(rr[0]) + __uint_as_float(rr[1]); }
#pragma unroll
          for (int i = 0; i < 8; ++i) { auto rr = __builtin_amdgcn_permlane16_swap(__float_as_uint(a16[i]), __float_as_uint(a16[i + 8]), false, false); a8[i] = __uint_as_float(rr[0]) + __uint_as_float(rr[1]); }
          const bool b3 = lane & 8, b2 = lane & 4, b1 = lane & 2;
#pragma unroll
          for (int i = 0; i < 4; ++i) { const float keep = b3 ? a8[i + 4] : a8[i], send = b3 ? a8[i] : a8[i + 4]; a4[i] = keep + WRED_DPP(send, 0x128); }
#pragma unroll
          for (int i = 0; i < 2; ++i) { const float keep = b2 ? a4[i + 2] : a4[i], send = b2 ? a4[i] : a4[i + 2]; const float s1 = WRED_DPP(send, 0x141); a2[i] = keep + WRED_DPP(s1, 0x1B); }
          float a1; { const float keep = b1 ? a2[1] : a2[0], send = b1 ? a2[0] : a2[1]; a1 = keep + WRED_DPP(send, 0x4E); }
          a1 += WRED_DPP(a1, 0xB1);
          if ((lane & 1) == 0) part[((lane >> 1) & 31) * 8 + wave] = a1; }
        __syncthreads();
        if (tid < CF_T) { float s = 0.f;
#pragma unroll
            for (int w = 0; w < 8; ++w) s += part[tid * 8 + w];
            part[CF_T * 8 + tid] = 1.0f / sqrtf(s * (1.0f / MIX_W) + EPS); }
        __syncthreads();
#pragma unroll
        for (int t = 0; t < CF_T; ++t) {
            const float v = outv[t] * part[CF_T * 8 + t] * gn; const float y = v * __builtin_amdgcn_rcpf(1.0f + __expf(-v));
            p.h[(size_t)(t0 + t) * (2 * MIX_W) + tid] = (bf16_t)(pk_bf16(y, 0.f) & 0xffffu); }
        __syncthreads();
    }
}


template <int CTRL> __device__ __forceinline__ float dpp_f(float v) { return __int_as_float(__builtin_amdgcn_update_dpp(0, __float_as_int(v), CTRL, 0xF, 0xF, true)); }
__device__ __forceinline__ float lane_xor1(float v) { return dpp_f<0xB1>(v); }
__device__ __forceinline__ float lane_xor2(float v) { return dpp_f<0x4E>(v); }
__device__ __forceinline__ float lane_xor4(float v) { return dpp_f<0x1B>(dpp_f<0x141>(v)); }
__device__ __forceinline__ float lane_xor8(float v) { return dpp_f<0x128>(v); }
__device__ __forceinline__ float pair32(float a, float b) { auto rr = __builtin_amdgcn_permlane32_swap(__float_as_uint(a), __float_as_uint(b), false, false); return __uint_as_float(rr[0]) + __uint_as_float(rr[1]); }
__device__ __forceinline__ float pair16(float a, float b) { auto rr = __builtin_amdgcn_permlane16_swap(__float_as_uint(a), __float_as_uint(b), false, false); return __uint_as_float(rr[0]) + __uint_as_float(rr[1]); }
#define G_ID(w, i) (((w)[(i) >> 1] >> (16 * ((i) & 1))) & 0xffffu)
__device__ __forceinline__ void g_rows(const unsigned char* base, const u32x4& ia, const u32x4& ib, u32x4 (&row)[16]) {
    unsigned w[8] = {ia[0], ia[1], ia[2], ia[3], ib[0], ib[1], ib[2], ib[3]};
#pragma unroll
    for (int i = 0; i < 16; ++i) row[i] = *(const u32x4*)(base + (size_t)G_ID(w, i) * 128);
}
__device__ __forceinline__ void g_dots_compute(const u32x4 (&r0)[16], const u32x4& h0, const u32x4& h1, int q, float& pdA, float& pdB) {
    f32x2 hv[8];
#pragma unroll
    for (int k = 0; k < 4; ++k) { hv[k] = (f32x2){bflo(h0[k]), bfhi(h0[k])}; hv[4 + k] = (f32x2){bflo(h1[k]), bfhi(h1[k])}; }
    float s[16];
#pragma unroll
    for (int i = 0; i < 16; ++i) { f32x2 a = (f32x2){0.f, 0.f};
#pragma unroll
        for (int k = 0; k < 4; ++k) { a = __builtin_amdgcn_cvt_pk_f32_fp8((int)r0[i][k], false) * hv[2 * k] + a; a = __builtin_amdgcn_cvt_pk_f32_fp8((int)r0[i][k], true) * hv[2 * k + 1] + a; }
        s[i] = a[0] + a[1]; }
    const bool qb2 = q & 4, qb1 = q & 2, qb0 = q & 1;
    float u8[8], u4[4];
#pragma unroll
    for (int m = 0; m < 2; ++m)
#pragma unroll
        for (int i = 0; i < 4; ++i) { const float keep = qb2 ? s[8 * m + i + 4] : s[8 * m + i], send = qb2 ? s[8 * m + i] : s[8 * m + i + 4]; u8[4 * m + i] = keep + lane_xor4(send); }
#pragma unroll
    for (int m = 0; m < 2; ++m)
#pragma unroll
        for (int i = 0; i < 2; ++i) { const float keep = qb1 ? u8[4 * m + i + 2] : u8[4 * m + i], send = qb1 ? u8[4 * m + i] : u8[4 * m + i + 2]; u4[2 * m + i] = keep + lane_xor2(send); }
    { const float keep = qb0 ? u4[1] : u4[0], send = qb0 ? u4[0] : u4[1]; pdA = keep + lane_xor1(send); }
    { const float keep = qb0 ? u4[3] : u4[2], send = qb0 ? u4[2] : u4[3]; pdB = keep + lane_xor1(send); }
}
__device__ __forceinline__ void phase_gather_dots(const P& p, int l, int ntok) {
    const int tid = tid_opaque(), lane = tid & 63, wave = tid >> 6, r = lane >> 3, q = lane & 7;
    const int nxg = (gridDim.x % 8 == 0) ? 8 : 1, xg = blockIdx.x % nxg, gwx = (blockIdx.x / nxg) * (NTHREADS / 64) + wave, ngwx = (gridDim.x / nxg) * (NTHREADS / 64);
    float* pd = p.bufB;
    for (int sl = xg; sl < 8; sl += nxg) {
        const unsigned char* Us = p.u8 + ((size_t)(l * 8 + sl) * PEER_EXPERTS) * 128 + 16 * q;
        const unsigned short* ip = p.pidx16 + 16 * r; const bf16_t* hp = p.h + 128 * sl + 16 * q;
        int t = gwx; if (t >= ntok) continue;
        u32x4 ra[16], rb[16], ia1, ib1, ia2, ib2, h0c, h1c, h0n, h1n;
        { const u32x4 ia0 = *(const u32x4*)(ip + (size_t)t * NPAIR), ib0 = *(const u32x4*)(ip + (size_t)t * NPAIR + 8); h0c = *(const u32x4*)(hp + (size_t)t * D_MODEL); h1c = *(const u32x4*)(hp + (size_t)t * D_MODEL + 8); g_rows(Us, ia0, ib0, ra); }
        int t1 = t + ngwx; { const int tc = t1 < ntok ? t1 : t; ia1 = *(const u32x4*)(ip + (size_t)tc * NPAIR); ib1 = *(const u32x4*)(ip + (size_t)tc * NPAIR + 8); }
#define GD_STEP(RC, RN) { \
            { const int t1c = t1 < ntok ? t1 : t; g_rows(Us, ia1, ib1, RN); h0n = *(const u32x4*)(hp + (size_t)t1c * D_MODEL); h1n = *(const u32x4*)(hp + (size_t)t1c * D_MODEL + 8); } \
            const int t2 = t1 + ngwx; { const int t2c = t2 < ntok ? t2 : t; ia2 = *(const u32x4*)(ip + (size_t)t2c * NPAIR); ib2 = *(const u32x4*)(ip + (size_t)t2c * NPAIR + 8); } \
            float pdA, pdB; g_dots_compute(RC, h0c, h1c, q, pdA, pdB); \
            pd[((size_t)sl * NT + t) * NPAIR + 16 * r + q] = pdA; pd[((size_t)sl * NT + t) * NPAIR + 16 * r + 8 + q] = pdB; \
            h0c = h0n; h1c = h1n; ia1 = ia2; ib1 = ib2; t = t1; t1 = t2; }
        while (t < ntok) { GD_STEP(ra, rb); if (t >= ntok) break; GD_STEP(rb, ra); }
#undef GD_STEP
    }
}
__device__ __forceinline__ void phase_gather_w(const P& p, int l, int ntok) {
    const float* pd = p.bufB; float* pw = (float*)p.bufA;
    const float* su = p.su + (size_t)l * PEER_EXPERTS; const float* svs = p.svs + (size_t)l * PEER_EXPERTS;
    const long n = (long)ntok * NPAIR;
    for (long i = (long)blockIdx.x * NTHREADS + tid_opaque(); i < n; i += (long)gridDim.x * NTHREADS) {
        float d = 0.f;
#pragma unroll
        for (int sl = 0; sl < 8; ++sl) d += pd[(size_t)sl * NT * NPAIR + i];
        const int e = p.pidx16[i]; pw[i] = p.pg[i] * gelu_fast(d * su[e]) * svs[e];
    }
}
__device__ __forceinline__ void g_out_compute(const u32x4 (&r0)[16], const f32x4 (&wv)[4], int r, f32x2& dd) {
    f32x2 acc[8];
#pragma unroll
    for (int k = 0; k < 8; ++k) acc[k] = (f32x2){0.f, 0.f};
#pragma unroll
    for (int i = 0; i < 16; ++i) { const float w = wv[i >> 2][i & 3]; const f32x2 w2 = (f32x2){w, w};
#pragma unroll
        for (int k = 0; k < 4; ++k) { acc[2 * k] = __builtin_amdgcn_cvt_pk_f32_fp8((int)r0[i][k], false) * w2 + acc[2 * k]; acc[2 * k + 1] = __builtin_amdgcn_cvt_pk_f32_fp8((int)r0[i][k], true) * w2 + acc[2 * k + 1]; } }
    float b8[8], c4[4];
#pragma unroll
    for (int n = 0; n < 8; ++n) b8[n] = pair32(acc[n >> 1][n & 1], acc[(n + 8) >> 1][n & 1]);
#pragma unroll
    for (int n = 0; n < 4; ++n) c4[n] = pair16(b8[n], b8[n + 4]);
    const bool rb0 = r & 1;
    { const float keep = rb0 ? c4[2] : c4[0], send = rb0 ? c4[0] : c4[2]; dd[0] = keep + lane_xor8(send); }
    { const float keep = rb0 ? c4[3] : c4[1], send = rb0 ? c4[1] : c4[3]; dd[1] = keep + lane_xor8(send); }
}
__device__ __forceinline__ void phase_gather_out(const P& p, int l, int ntok) {
    const int tid = tid_opaque(), lane = tid & 63, wave = tid >> 6, r = lane >> 3, q = lane & 7;
    const int nxg = (gridDim.x % 8 == 0) ? 8 : 1, xg = blockIdx.x % nxg, gwx = (blockIdx.x / nxg) * (NTHREADS / 64) + wave, ngwx = (gridDim.x / nxg) * (NTHREADS / 64);
    const bool last = l == DEPTH - 1;
    for (int sl = xg; sl < 8; sl += nxg) {
        const unsigned char* Vs = p.v8 + ((size_t)(l * 8 + sl) * PEER_EXPERTS) * 128 + 16 * q;
        const unsigned short* ip = p.pidx16 + 16 * r; const float* wp = (const float*)p.bufA + 16 * r;
        const int dof = 128 * sl + 16 * q + 2 * r;
        int t = gwx; if (t >= ntok) continue;
        u32x4 ra[16], rb[16], ia1, ib1, ia2, ib2; f32x4 wc[4], wn[4]; f32x2 gc, xc, gn, xn;
        { const u32x4 ia0 = *(const u32x4*)(ip + (size_t)t * NPAIR), ib0 = *(const u32x4*)(ip + (size_t)t * NPAIR + 8);
#pragma unroll
          for (int k = 0; k < 4; ++k) wc[k] = *(const f32x4*)(wp + (size_t)t * NPAIR + 4 * k);
          gc = *(const f32x2*)(ada_ptr(p, l, t, 5) + dof); xc = *(const f32x2*)(p.xcur + (size_t)t * D_MODEL + dof); g_rows(Vs, ia0, ib0, ra); }
        int t1 = t + ngwx; { const int tc = t1 < ntok ? t1 : t; ia1 = *(const u32x4*)(ip + (size_t)tc * NPAIR); ib1 = *(const u32x4*)(ip + (size_t)tc * NPAIR + 8); }
#define GO_STEP(RC, RN) { \
            { const int t1c = t1 < ntok ? t1 : t; g_rows(Vs, ia1, ib1, RN); _Pragma("unroll") for (int k = 0; k < 4; ++k) wn[k] = *(const f32x4*)(wp + (size_t)t1c * NPAIR + 4 * k); \
                gn = *(const f32x2*)(ada_ptr(p, l, t1c, 5) + dof); xn = *(const f32x2*)(p.xcur + (size_t)t1c * D_MODEL + dof); } \
            const int t2 = t1 + ngwx; { const int t2c = t2 < ntok ? t2 : t; ia2 = *(const u32x4*)(ip + (size_t)t2c * NPAIR); ib2 = *(const u32x4*)(ip + (size_t)t2c * NPAIR + 8); } \
            f32x2 dd; g_out_compute(RC, wc, r, dd); \
            *(f32x2*)((last ? p.out : p.xcur) + (size_t)t * D_MODEL + dof) = xc + gc * dd; \
            _Pragma("unroll") for (int k = 0; k < 4; ++k) wc[k] = wn[k]; gc = gn; xc = xn; ia1 = ia2; ib1 = ib2; t = t1; t1 = t2; }
        while (t < ntok) { GO_STEP(ra, rb); if (t >= ntok) break; GO_STEP(rb, ra); }
#undef GO_STEP
    }
}


#define FP4_TOP 6.0f
#ifdef DBG_FP4
#define DBG_SCALE(ov) { const unsigned _c = p.bar[DBG_WORD]; if (last && _c) ov = ov * (1.0f + 0.1f * (1.0f + log10f((float)_c))); }
#else
#define DBG_SCALE(ov)
#endif
__device__ __forceinline__ void convert4_finish(const f32x4 (&v)[4], unsigned char* dst, size_t slice_stride, float* scale_out, int lane, unsigned* dbgw) {
    float m = 0.f;
#pragma unroll
    for (int i = 0; i < 4; ++i) m = fmaxf(m, fmaxf(fmaxf(fabsf(v[i][0]), fabsf(v[i][1])), fmaxf(fabsf(v[i][2]), fabsf(v[i][3]))));
    m = wave_max(m);
    const float inv = m > 0.f ? FP4_TOP / m : 0.f;
    unsigned wq[4];
#pragma unroll
    for (int i = 0; i < 4; ++i) { unsigned w = 0u; w = __builtin_amdgcn_cvt_scalef32_pk_fp4_f32(w, v[i][0] * inv, v[i][1] * inv, 1.0f, 0); w = __builtin_amdgcn_cvt_scalef32_pk_fp4_f32(w, v[i][2] * inv, v[i][3] * inv, 1.0f, 1);
        wq[i] = w & 0xffffu;
#ifdef DBG_FP4
        { const f32x2 d01 = __builtin_amdgcn_cvt_scalef32_pk_f32_fp4(w, 1.0f, 0), d23 = __builtin_amdgcn_cvt_scalef32_pk_f32_fp4(w, 1.0f, 1);
          const float e0 = fabsf(d01[0] - v[i][0] * inv), e1 = fabsf(d01[1] - v[i][1] * inv), e2 = fabsf(d23[0] - v[i][2] * inv), e3 = fabsf(d23[1] - v[i][3] * inv);
          if (!(e0 <= 1.01f && e1 <= 1.01f && e2 <= 1.01f && e3 <= 1.01f)) atomicAdd(dbgw, 1u); }
#endif
        }
    *(u32x2*)(dst + (size_t)(lane & 3) * slice_stride + 8 * (lane >> 2)) = quad_gather16(wq[0], wq[1], wq[2], wq[3], lane);
    if (lane == 0) *scale_out = m > 0.f ? m / FP4_TOP : 0.f;
}
#define I4_CLIP 2.5f
__device__ __forceinline__ void convert_i4_finish(const f32x4 (&v)[4], unsigned char* dst, size_t slice_stride, float* scale_out, int lane) {
    float ss = 0.f;
#pragma unroll
    for (int i = 0; i < 4; ++i) ss += (v[i][0] * v[i][0] + v[i][1] * v[i][1]) + (v[i][2] * v[i][2] + v[i][3] * v[i][3]);
    const float rms = sqrtf(wave_sum(ss) * (1.0f / D_MODEL));
    const float inv = rms > 0.f ? 7.0f / (I4_CLIP * rms) : 0.f;
    unsigned wq[4];
#pragma unroll
    for (int i = 0; i < 4; ++i) { wq[i] = 0u;
#pragma unroll
        for (int j = 0; j < 4; ++j) { const int q = (int)rintf(fminf(fmaxf(v[i][j] * inv, -7.0f), 7.0f)); wq[i] |= (unsigned)(q & 15) << (4 * j); } }
    *(u32x2*)(dst + (size_t)(lane & 3) * slice_stride + 8 * (lane >> 2)) = quad_gather16(wq[0], wq[1], wq[2], wq[3], lane);
    if (lane == 0) *scale_out = I4_CLIP * rms * (1.0f / 7.0f);
}
__device__ __forceinline__ void phase_peer_tables4(const P& p) {
    const int tid = tid_opaque(); const int lane = tid & 63, gw = blockIdx.x * (NTHREADS / 64) + (tid >> 6), ngw = gridDim.x * (NTHREADS / 64);
    const int R = DEPTH * PEER_EXPERTS;
    for (int r0 = gw; r0 < R; r0 += 4 * ngw) {
        f32x4 v[4][4];
#pragma unroll
        for (int k = 0; k < 4; ++k) { const int row = r0 + k * ngw; if (row < R) { const float* srcp = p.peer_u + (size_t)row * D_MODEL;
#pragma unroll
            for (int i = 0; i < 4; ++i) v[k][i] = ((const f32x4*)srcp)[i * 64 + lane]; } }
#pragma unroll
        for (int k = 0; k < 4; ++k) { const int row = r0 + k * ngw; if (row < R)
            convert_i4_finish(v[k], p.u8 + ((size_t)(row / PEER_EXPERTS) * 4 * PEER_EXPERTS + (row % PEER_EXPERTS)) * 128, (size_t)PEER_EXPERTS * 128, p.su + row, lane); }
    }
    for (int r0 = gw; r0 < R; r0 += 4 * ngw) {
        f32x4 v[4][4];
#pragma unroll
        for (int k = 0; k < 4; ++k) { const int row = r0 + k * ngw; if (row < R) { const float* srcp = p.peer_v + (size_t)row * D_MODEL;
#pragma unroll
            for (int i = 0; i < 4; ++i) v[k][i] = ((const f32x4*)srcp)[i * 64 + lane]; } }
#pragma unroll
        for (int k = 0; k < 4; ++k) { const int row = r0 + k * ngw; if (row < R)
            convert4_finish(v[k], p.v8 + ((size_t)(row / PEER_EXPERTS) * 4 * PEER_EXPERTS + (row % PEER_EXPERTS)) * 128, (size_t)PEER_EXPERTS * 128, p.svs + row, lane, p.bar + DBG_WORD); }
    }
}
struct G4Place { int nsl, sl0, tsub, ntsub, gwx, ngwx; };
__device__ __forceinline__ G4Place g4_place(int wave) {
    G4Place g; const int nxg = (gridDim.x % 8 == 0) ? 8 : 1, xg = blockIdx.x % nxg;
    g.gwx = (blockIdx.x / nxg) * (NTHREADS / 64) + wave; g.ngwx = (gridDim.x / nxg) * (NTHREADS / 64);
    if (nxg == 8) { g.nsl = 1; g.sl0 = xg & 3; g.tsub = xg >> 2; g.ntsub = 2; } else { g.nsl = 4; g.sl0 = 0; g.tsub = 0; g.ntsub = 1; }
    return g; }
__device__ __forceinline__ void g4_dots_compute(const u32x4 (&r0)[16], const u32x4& ha, const u32x4& hb, int q, float& pdA, float& pdB) {
    float s[16];
#pragma unroll
    for (int i = 0; i < 16; ++i) { int a = 0, c2 = 0;
#pragma unroll
        for (int k = 0; k < 4; ++k) { a = __builtin_amdgcn_sdot8((int)r0[i][k], (int)ha[k], a, false); c2 = __builtin_amdgcn_sdot8((int)r0[i][k], (int)hb[k], c2, false); }
        s[i] = (float)(16 * a + c2); }
    const bool qb2 = q & 4, qb1 = q & 2, qb0 = q & 1;
    float u8[8], u4[4];
#pragma unroll
    for (int m = 0; m < 2; ++m)
#pragma unroll
        for (int i = 0; i < 4; ++i) { const float keep = qb2 ? s[8 * m + i + 4] : s[8 * m + i], send = qb2 ? s[8 * m + i] : s[8 * m + i + 4]; u8[4 * m + i] = keep + lane_xor4(send); }
#pragma unroll
    for (int m = 0; m < 2; ++m)
#pragma unroll
        for (int i = 0; i < 2; ++i) { const float keep = qb1 ? u8[4 * m + i + 2] : u8[4 * m + i], send = qb1 ? u8[4 * m + i] : u8[4 * m + i + 2]; u4[2 * m + i] = keep + lane_xor2(send); }
    { const float keep = qb0 ? u4[1] : u4[0], send = qb0 ? u4[0] : u4[1]; pdA = keep + lane_xor1(send); }
    { const float keep = qb0 ? u4[3] : u4[2], send = qb0 ? u4[2] : u4[3]; pdB = keep + lane_xor1(send); }
}
__device__ __forceinline__ void phase_gather4_dots(const P& p, int l, int ntok) {
    const int tid = tid_opaque(), lane = tid & 63, wave = tid >> 6, r = lane >> 3, q = lane & 7;
    const G4Place gp = g4_place(wave);
    float* pd = p.bufB;
    for (int si = 0; si < gp.nsl; ++si) { const int sl = gp.sl0 + si;
        const unsigned char* Us = p.u8 + ((size_t)(l * 4 + sl) * PEER_EXPERTS) * 128 + 16 * q;
        const unsigned short* ip = p.pidx16 + 16 * r; const unsigned char* hp = p.hq + 128 * sl + 16 * q;
        const int step = gp.ntsub * gp.ngwx; int t = gp.tsub + gp.ntsub * gp.gwx; if (t >= ntok) continue;
        u32x4 ra[16], rb[16], ia1, ib1, ia2, ib2, hac, hbc, han, hbn;
        { const u32x4 ia0 = *(const u32x4*)(ip + (size_t)t * NPAIR), ib0 = *(const u32x4*)(ip + (size_t)t * NPAIR + 8);
          hac = *(const u32x4*)(hp + (size_t)t * D_MODEL); hbc = *(const u32x4*)(hp + (size_t)t * D_MODEL + 512);
          g_rows(Us, ia0, ib0, ra); }
        int t1 = t + step; { const int tc = t1 < ntok ? t1 : t; ia1 = *(const u32x4*)(ip + (size_t)tc * NPAIR); ib1 = *(const u32x4*)(ip + (size_t)tc * NPAIR + 8); }
#define G4D_STEP(RC, RN) { \
            { const int t1c = t1 < ntok ? t1 : t; g_rows(Us, ia1, ib1, RN); han = *(const u32x4*)(hp + (size_t)t1c * D_MODEL); hbn = *(const u32x4*)(hp + (size_t)t1c * D_MODEL + 512); } \
            const int t2 = t1 + step; { const int t2c = t2 < ntok ? t2 : t; ia2 = *(const u32x4*)(ip + (size_t)t2c * NPAIR); ib2 = *(const u32x4*)(ip + (size_t)t2c * NPAIR + 8); } \
            float pdA, pdB; g4_dots_compute(RC, hac, hbc, q, pdA, pdB); \
            pd[((size_t)sl * NT + t) * NPAIR + 16 * r + q] = pdA; pd[((size_t)sl * NT + t) * NPAIR + 16 * r + 8 + q] = pdB; \
            hac = han; hbc = hbn; ia1 = ia2; ib1 = ib2; t = t1; t1 = t2; }
        while (t < ntok) { G4D_STEP(ra, rb); if (t >= ntok) break; G4D_STEP(rb, ra); }
#undef G4D_STEP
    }
}
__device__ __forceinline__ void phase_gather4_w(const P& p, int l, int ntok) {
    const float* pd = p.bufB; unsigned* pw = (unsigned*)p.bufA;
    const float* su = p.su + (size_t)l * PEER_EXPERTS; const float* svs = p.svs + (size_t)l * PEER_EXPERTS;
    const long n4 = (long)ntok * NPAIR / 4;
    for (long i4 = (long)blockIdx.x * NTHREADS + tid_opaque(); i4 < n4; i4 += (long)gridDim.x * NTHREADS) {
        const long i = 4 * i4;
        f32x4 d = *(const f32x4*)(pd + i);
#pragma unroll
        for (int sl = 1; sl < 4; ++sl) d += *(const f32x4*)(pd + (size_t)sl * NT * NPAIR + i);
        const u32x2 ev = *(const u32x2*)(p.pidx16 + i); const f32x4 g = *(const f32x4*)(p.pg + i); const float sh = p.sh[i / NPAIR];
        const int e[4] = {(int)(ev.x & 0xffffu), (int)(ev.x >> 16), (int)(ev.y & 0xffffu), (int)(ev.y >> 16)};
        float sue[4], sve[4];
#pragma unroll
        for (int k = 0; k < 4; ++k) { sue[k] = su[e[k]]; sve[k] = svs[e[k]]; }
        u32x4 o;
#pragma unroll
        for (int k = 0; k < 4; ++k) { const float w = g[k] * gelu_fast(d[k] * sue[k] * sh) * sve[k];
            const _Float16 h = (_Float16)fminf(fmaxf(w * 1024.0f, -60000.0f), 60000.0f); const unsigned hb = (unsigned)__builtin_bit_cast(unsigned short, h);
            o[k] = hb | (hb << 16); }
        *(u32x4*)(pw + i) = o;
    }
}
typedef _Float16 f16v8 __attribute__((ext_vector_type(8)));
__device__ __forceinline__ f16v2 pair32h(f16v2 a, f16v2 b) { auto rr = __builtin_amdgcn_permlane32_swap(__builtin_bit_cast(unsigned, a), __builtin_bit_cast(unsigned, b), false, false);
    unsigned x = rr[0], y = rr[1]; asm volatile("" : "+v"(x), "+v"(y)); return __builtin_bit_cast(f16v2, x) + __builtin_bit_cast(f16v2, y); }
__device__ __forceinline__ f16v2 pair16h(f16v2 a, f16v2 b) { auto rr = __builtin_amdgcn_permlane16_swap(__builtin_bit_cast(unsigned, a), __builtin_bit_cast(unsigned, b), false, false);
    unsigned x = rr[0], y = rr[1]; asm volatile("" : "+v"(x), "+v"(y)); return __builtin_bit_cast(f16v2, x) + __builtin_bit_cast(f16v2, y); }
__device__ __forceinline__ void g4_out_compute(const u32x4 (&r0)[16], const u32x4 (&wv)[4], int r, f32x4& dd) {
    f16v2 acc16[16];
#pragma unroll
    for (int k = 0; k < 16; ++k) acc16[k] = (f16v2){(_Float16)0.f, (_Float16)0.f};
#pragma unroll
    for (int i = 0; i < 16; ++i) { const f16v8 w8 = __builtin_bit_cast(f16v8, wv[i >> 2]);
        const f16v2 w2 = (i & 3) == 0 ? __builtin_shufflevector(w8, w8, 0, 1) : (i & 3) == 1 ? __builtin_shufflevector(w8, w8, 2, 3) : (i & 3) == 2 ? __builtin_shufflevector(w8, w8, 4, 5) : __builtin_shufflevector(w8, w8, 6, 7);
#pragma unroll
        for (int k = 0; k < 4; ++k) {
            acc16[4 * k + 0] = __builtin_amdgcn_cvt_scalef32_pk_f16_fp4(r0[i][k], 1.0f, 0) * w2 + acc16[4 * k + 0]; acc16[4 * k + 1] = __builtin_amdgcn_cvt_scalef32_pk_f16_fp4(r0[i][k], 1.0f, 1) * w2 + acc16[4 * k + 1];
            acc16[4 * k + 2] = __builtin_amdgcn_cvt_scalef32_pk_f16_fp4(r0[i][k], 1.0f, 2) * w2 + acc16[4 * k + 2]; acc16[4 * k + 3] = __builtin_amdgcn_cvt_scalef32_pk_f16_fp4(r0[i][k], 1.0f, 3) * w2 + acc16[4 * k + 3]; } }
    f16v2 p8[8], q4[4];
#pragma unroll
    for (int j = 0; j < 8; ++j) p8[j] = pair32h(acc16[j], acc16[j + 8]);
#pragma unroll
    for (int j = 0; j < 4; ++j) q4[j] = pair16h(p8[j], p8[j + 4]);
    const bool rb0 = r & 1;
#pragma unroll
    for (int j = 0; j < 2; ++j) { const unsigned keep = __builtin_bit_cast(unsigned, rb0 ? q4[j + 2] : q4[j]), send = __builtin_bit_cast(unsigned, rb0 ? q4[j] : q4[j + 2]);
        unsigned got = (unsigned)__builtin_amdgcn_update_dpp(0, (int)send, 0x128, 0xF, 0xF, true), kp = keep; asm volatile("" : "+v"(got), "+v"(kp));
        const f16v2 s2 = __builtin_bit_cast(f16v2, kp) + __builtin_bit_cast(f16v2, got);
        dd[2 * j] = (float)s2[0] * (1.0f / 1024.0f); dd[2 * j + 1] = (float)s2[1] * (1.0f / 1024.0f); }
}
__device__ __forceinline__ void phase_gather4_out(const P& p, int l, int ntok) {
    const int tid = tid_opaque(), lane = tid & 63, wave = tid >> 6, r = lane >> 3, q = lane & 7;
    const G4Place gp = g4_place(wave);
    const bool last = l == DEPTH - 1;
    for (int si = 0; si < gp.nsl; ++si) { const int sl = gp.sl0 + si;
        const unsigned char* Vs = p.v8 + ((size_t)(l * 4 + sl) * PEER_EXPERTS) * 128 + 16 * q;
        const unsigned short* ip = p.pidx16 + 16 * r; const unsigned* wp = (const unsigned*)p.bufA + 16 * r;
        const int dof = 256 * sl + 32 * q + 4 * r;
        const int step = gp.ntsub * gp.ngwx; int t = gp.tsub + gp.ntsub * gp.gwx; if (t >= ntok) continue;
        u32x4 ra[16], rb[16], ia1, ib1, ia2, ib2, wc[4], wn[4]; f32x4 gc, gn; u32x2 xc, xn;
        { const u32x4 ia0 = *(const u32x4*)(ip + (size_t)t * NPAIR), ib0 = *(const u32x4*)(ip + (size_t)t * NPAIR + 8);
#pragma unroll
          for (int k = 0; k < 4; ++k) wc[k] = *(const u32x4*)(wp + (size_t)t * NPAIR + 4 * k);
          gc = *(const f32x4*)(ada_ptr(p, l, t, 5) + dof); xc = *(const u32x2*)(p.xb + (size_t)t * D_MODEL + dof); g_rows(Vs, ia0, ib0, ra); }
        int t1 = t + step; { const int tc = t1 < ntok ? t1 : t; ia1 = *(const u32x4*)(ip + (size_t)tc * NPAIR); ib1 = *(const u32x4*)(ip + (size_t)tc * NPAIR + 8); }
#define G4O_STEP(RC, RN) { \
            { const int t1c = t1 < ntok ? t1 : t; g_rows(Vs, ia1, ib1, RN); _Pragma("unroll") for (int k = 0; k < 4; ++k) wn[k] = *(const u32x4*)(wp + (size_t)t1c * NPAIR + 4 * k); \
                gn = *(const f32x4*)(ada_ptr(p, l, t1c, 5) + dof); xn = *(const u32x2*)(p.xb + (size_t)t1c * D_MODEL + dof); } \
            const int t2 = t1 + step; { const int t2c = t2 < ntok ? t2 : t; ia2 = *(const u32x4*)(ip + (size_t)t2c * NPAIR); ib2 = *(const u32x4*)(ip + (size_t)t2c * NPAIR + 8); } \
            f32x4 dd; g4_out_compute(RC, wc, r, dd); \
            { f32x4 ov = (f32x4){__uint_as_float(xc.x << 16), __uint_as_float(xc.x & 0xffff0000u), __uint_as_float(xc.y << 16), __uint_as_float(xc.y & 0xffff0000u)} + gc * dd; DBG_SCALE(ov); \
              if (last) *(f32x4*)(p.out + (size_t)t * D_MODEL + dof) = ov; else { u32x2 w; w.x = pk_bf16(ov[0], ov[1]); w.y = pk_bf16(ov[2], ov[3]); *(u32x2*)(p.xb + (size_t)t * D_MODEL + dof) = w; } } \
            _Pragma("unroll") for (int k = 0; k < 4; ++k) wc[k] = wn[k]; gc = gn; xc = xn; ia1 = ia2; ib1 = ib2; t = t1; t1 = t2; }
        while (t < ntok) { G4O_STEP(ra, rb); if (t >= ntok) break; G4O_STEP(rb, ra); }
#undef G4O_STEP
    }
}

#ifndef PROBE_DUP
#define PROBE_DUP 0
#endif
#define DUP(bit) for (int _d = 0; _d < (((PROBE_DUP) >> (bit)) & 1) + 1; ++_d)
struct DevRunner {
    const P& p; const XcdBarrier& b; LAS unsigned char* lds;
    __device__ __forceinline__ void prologue() { DUP(7) { phase_ada(p, lds); phase_weights(p, lds); phase_wsb(p); phase_rope_table(p); phase_peer_tables4(p); xcd_barrier(b); } }
    __device__ __forceinline__ void norm_first() { DUP(6) { phase_norm(p, 0, 0, NT, true); xcd_barrier(b); } }
    __device__ __forceinline__ void norm2(int l, long nt2) { DUP(6) { phase_norm(p, l, 1, (int)nt2, false); xcd_barrier(b); } }
    __device__ __forceinline__ void even_mixer(int l) { DUP(4) { phase_even_mixer(p, lds, l); xcd_barrier(b); } }
    __device__ __forceinline__ void odd_conformer(int l) { DUP(5) { phase_conformer(p, lds, l); } }
    __device__ __forceinline__ void odd_attention(int l) { DUP(2) { phase_attn_prep(p, l); xcd_barrier(b); phase_attention(p, lds, l); xcd_barrier(b); } }
    __device__ __forceinline__ void peer_topk(int l, long nt2) { DUP(3) { phase_peer_topk(p, lds, l, (int)nt2); xcd_barrier(b); } }
    __device__ __forceinline__ void peer_gather(int l, long nt2) {
        DUP(1) { phase_gather4_dots(p, l, (int)nt2); xcd_barrier(b); phase_gather4_w(p, l, (int)nt2); xcd_barrier(b); }
        phase_gather4_out(p, l, (int)nt2);
        if (l != DEPTH - 1) { xcd_barrier(b); phase_norm(p, l + 1, 0, NT, false); xcd_barrier(b); } }
    __device__ __forceinline__ void gemm_in(int l) {
        const bool part = (l == DEPTH - 1) && (l & 1);
        pg8::Gemm g{p.h, p.wt_in + (size_t)l * IN_W * D_MODEL, NT, IN_W, D_MODEL}; pg8::XcdOrder S; S.init(part ? NLAT / 256 : NT / 256, NT / 256, IN_W / 256, 3 * MIX_W / 256);
        DUP(0) { pg8::gemm_phase<pg8::EpiStoreBf16, pg8::XcdOrder, true, true>(lds + 1024, g, S, pg8::EpiStoreBf16{p.bufA, IN_W, (l % 2 == 0) ? 3 * MIX_W : (1 << 30), p.vss, (l % 2 == 0) ? 4 * MIX_W : (1 << 30)}); xcd_barrier(b); } }
    __device__ __forceinline__ void gemm_out(int l, long nt2) {
        const int ntm = (l == 0) ? NLAT / 256 : (int)(nt2 / 256);
        pg8::Gemm g{p.h, p.wt_out + (size_t)l * D_MODEL * 2 * MIX_W, (int)nt2, D_MODEL, 2 * MIX_W}; pg8::XcdOrder S; S.init(ntm, ntm, D_MODEL / 256, 0);
        if ((PROBE_DUP) & 1) { pg8::gemm_phase<pg8::EpiResidual, pg8::XcdOrder, true, true>(lds + 1024, g, S, pg8::EpiResidual{p.x, p.ctx, l == 0 ? (const bf16_t*)nullptr : p.xb, (bf16_t*)p.bufB, p.ada, l}); xcd_barrier(b); }
        pg8::gemm_phase<pg8::EpiResidual, pg8::XcdOrder, true, true>(lds + 1024, g, S, pg8::EpiResidual{p.x, p.ctx, l == 0 ? (const bf16_t*)nullptr : p.xb, p.xb, p.ada, l});
        if (l == 0) gemm_small<1>(lds, p.h, p.wt_out, 2 * MIX_W, NLAT, NCTX / 128, D_MODEL / 64, EpiRes{p.x, p.ctx, p.xb, p.ada, 0});
        xcd_barrier(b); }
    __device__ __forceinline__ void gemm_q(int l, long nt2) {
        const int ntm = (l == 0) ? NLAT / 256 : (int)(nt2 / 256);
        pg8::Gemm g{p.h, p.wt_q + (size_t)l * PQW * D_MODEL, (int)nt2, PQW, D_MODEL}; pg8::XcdOrder S; S.init(ntm, ntm, PQW / 256, 0);
        DUP(0) { pg8::gemm_phase<pg8::EpiStoreBf16, pg8::XcdOrder, true, true>(lds + 1024, g, S, pg8::EpiStoreBf16{p.bufA, PQW, 1 << 30, p.vss, 1 << 30});
            if (l == 0) gemm_small<2>(lds, p.h, p.wt_q, D_MODEL, NLAT, NCTX / 128, PQW / 128, EpiBf16{p.bufA, PQW});
            xcd_barrier(b); } }
    template <nv_body_t F> __device__ __forceinline__ void run(long n, int l, int aux) {
        const long stride = (long)gridDim.x * NTHREADS;
        for (long g = (long)blockIdx.x * NTHREADS + tid_opaque(); g < n; g += stride) F(g, p, l, aux);
        xcd_barrier(b);
    }
};

__global__ void __launch_bounds__(NTHREADS, 2) megakernel(P p) {
    __shared__ __attribute__((aligned(16))) unsigned char lds[LDS_BYTES];
    volatile LAS unsigned* st = (volatile LAS unsigned*)(LAS unsigned char*)lds;
    if (threadIdx.x < 4) st[threadIdx.x] = 0u;
    __syncthreads();
    const XcdBarrier b = xcd_barrier_post(p.bar, st);
    DevRunner r{p, b, (LAS unsigned char*)lds};
    naive_forward(r, p);
}

extern "C" void kernel_launch(void* const* d_in, const int* in_sizes, int n_in, void* d_out, int out_size, void* d_ws, size_t ws_size, hipStream_t stream) {
    P p{};
    const float** ip = (const float**)&p.x;
    for (int i = 0; i < 24; ++i) ip[i] = (const float*)d_in[i];
    p.out = (float*)d_out;
    const size_t need = carve_ws(p, (char*)d_ws);
    if (need > ws_size) return;
    static int grid = 0;
    if (grid == 0) { int dev = 0, cus = 0; hipGetDevice(&dev); hipDeviceGetAttribute(&cus, hipDeviceAttributeMultiprocessorCount, dev); grid = cus > 0 ? cus : 256; }
    (void)hipMemsetAsync(p.bar, 0, (size_t)BAR_ALLOC_WORDS * 4, stream);
    hipLaunchKernelGGL(megakernel, dim3(grid), dim3(NTHREADS), 0, stream, p);
}
#endif
```

```cpp
#ifndef HOST_TEST
#include <hip/hip_runtime.h>
#define HD __host__ __device__ __forceinline__
#else
#define HD inline
#endif
#include <math.h>
#include <stdint.h>
#include <stddef.h>

#ifndef D_MODEL
#define D_MODEL 1024
#define BATCH 8
#define SEQ 2048
#define CTX_LEN 256
#define MIX_W 512
#define B_GROUPS 8
#define D_HEADS 4
#define D_HEAD_DIM 64
#define PEER_HEADS 8
#define PEER_KEYS 128
#define PEER_QDIM 256
#define PEER_TOPK 16
#endif
#define DEPTH 2
#define GRID_W 64
#define IN_W (5 * MIX_W)
#define A_CONV 3
#define CHUNK 128
#define C_CONV 31
#define ROPE_THETA 10000.0f
#define N_ADA 6
#define PEER_EXPERTS (PEER_KEYS * PEER_KEYS)
#define EPS 1e-6f
#define NLAT (BATCH * SEQ)
#define NCTX (BATCH * CTX_LEN)
#define NT (NLAT + NCTX)
#define LKV (CTX_LEN + SEQ)
#define PQW (PEER_HEADS * PEER_QDIM)
#define NPAIR (PEER_HEADS * PEER_TOPK)
#define BGC (MIX_W / B_GROUPS)
#define XCD_BAR_WORDS 3456
#define BAR_ALLOC_WORDS 4096
#define DBG_WORD 3584

typedef unsigned short bf16_t;
struct P {
    const float *x, *c, *ctx, *c_ctx, *w_ada, *b_ada, *norm1_g, *norm2_g, *w_in, *w_out, *a_conv_w, *b_vnorm_g, *b_spatial_w,
        *b_spatial_b, *c_conv_w, *c_conv_b, *c_norm_g, *d_qk_norm_g, *d_lambda, *d_subln_g, *peer_wq, *peer_subkeys, *peer_u, *peer_v;
    float* out;
    unsigned* bar;
    float *ada;
    float *xcur;
    bf16_t *xb;
    bf16_t *h;
    bf16_t *bufA;
    float *bufB;
    float *rstd;
    float *sv; int *si;
    int *pidx; float *pg;
    float *pw;
    bf16_t *wt_in, *wt_out, *wt_q;
    unsigned char *u8, *v8;
    float *su, *svs;
    unsigned short *pidx16;
    float *vss;
    unsigned char *hq; float *sh;
    bf16_t *wsb;
    float *rope;
    bf16_t *qp, *kp, *vt;
};
HD float bf2f(bf16_t v) { union { unsigned u; float f; } c; c.u = (unsigned)v << 16; return c.f; }
HD bf16_t f2bf(float f) { union { unsigned u; float f; } c; c.f = f; unsigned u = c.u; u += 0x7fffu + ((u >> 16) & 1u); return (bf16_t)(u >> 16); }

HD float gelu_f(float x) { return 0.5f * x * (1.0f + tanhf(0.7978845608028654f * (x + 0.044715f * x * x * x))); }
HD float sigmoid_f(float x) { return 1.0f / (1.0f + expf(-x)); }
HD float silu_f(float x) { return x * sigmoid_f(x); }
HD int tok_adarow(int t) { return t < NLAT ? t / SEQ : BATCH; }
HD int tok_pos(int t) { return t < NLAT ? t % SEQ : (t - NLAT) % CTX_LEN; }
HD int tok_len(int t) { return t < NLAT ? SEQ : CTX_LEN; }
HD const float* ada_ptr(const P& p, int l, int t, int which) { return p.ada + ((size_t)(l * (BATCH + 1) + tok_adarow(t)) * N_ADA + which) * D_MODEL; }

HD void nv_ada(long gid, const P& p, int, int) {
    const int j = (int)(gid % (N_ADA * D_MODEL)); const int r = (int)((gid / (N_ADA * D_MODEL)) % (BATCH + 1)); const int l = (int)(gid / ((long)(N_ADA * D_MODEL) * (BATCH + 1)));
    const float* cv = r < BATCH ? p.c + (size_t)r * D_MODEL : p.c_ctx;
    const float* w = p.w_ada + (size_t)l * D_MODEL * N_ADA * D_MODEL + j;
    float acc = p.b_ada[(size_t)l * N_ADA * D_MODEL + j];
    for (int i = 0; i < D_MODEL; ++i) acc += silu_f(cv[i]) * w[(size_t)i * N_ADA * D_MODEL];
    p.ada[gid] = acc;
}
HD void nv_copy_in(long gid, const P& p, int, int) {
    const long nl = (long)NLAT * D_MODEL;
    p.xcur[gid] = gid < nl ? p.x[gid] : p.ctx[gid - nl];
}
HD void nv_copy_out(long gid, const P& p, int, int) {
    float v = p.xcur[gid];
#ifdef DBG_CHECK
    const unsigned cnt = p.bar[DBG_WORD]; if (cnt) v *= 1.0f + 0.1f * (1.0f + log10f((float)cnt));
#endif
    p.out[gid] = v; }
#ifdef DBG_CHECK
HD void nv_cmp_bf16(long gid, const P& p, int, int) {
    const float a = bf2f(p.bufA[gid]), b = bf2f(((const bf16_t*)p.bufB)[gid]);
    if (!(fabsf(a - b) <= 0.05f * (fabsf(a) + fabsf(b)) + 5e-2f)) {
#ifndef HOST_TEST
        atomicAdd(&p.bar[DBG_WORD], 1u);
#endif
    }
}
#endif
HD void nv_rstd(long gid, const P& p, int, int) {
    const float* r = p.xcur + (size_t)gid * D_MODEL; float s = 0.f;
    for (int i = 0; i < D_MODEL; ++i) s += r[i] * r[i];
    p.rstd[gid] = 1.0f / sqrtf(s / D_MODEL + EPS);
}
HD void nv_mod(long gid, const P& p, int l, int which) {
    const int t = (int)(gid / D_MODEL), j = (int)(gid % D_MODEL);
    const float g = (which ? p.norm2_g : p.norm1_g)[l * D_MODEL + j];
    const float sh = ada_ptr(p, l, t, which ? 3 : 0)[j], sc = ada_ptr(p, l, t, which ? 4 : 1)[j];
    p.h[gid] = f2bf(p.xcur[gid] * p.rstd[t] * g * (1.0f + sc) + sh);
}
HD void nv_gemm_in(long gid, const P& p, int l, int) {
    const int t = (int)(gid / IN_W), n = (int)(gid % IN_W);
    const bf16_t* a = p.h + (size_t)t * D_MODEL; const float* w = p.w_in + (size_t)l * D_MODEL * IN_W + n; float acc = 0.f;
    for (int k = 0; k < D_MODEL; ++k) acc += bf2f(a[k]) * w[(size_t)k * IN_W];
    p.bufA[gid] = f2bf(acc);
}
HD void nv_gemm_out(long gid, const P& p, int l, int) {
    const int t = (int)(gid / D_MODEL), n = (int)(gid % D_MODEL);
    const bf16_t* a = p.h + (size_t)t * (2 * MIX_W); const float* w = p.w_out + (size_t)l * (2 * MIX_W) * D_MODEL + n; float acc = 0.f;
    for (int k = 0; k < 2 * MIX_W; ++k) acc += bf2f(a[k]) * w[(size_t)k * D_MODEL];
    p.xcur[gid] += ada_ptr(p, l, t, 2)[n] * acc;
}
HD void nv_gemm_q(long gid, const P& p, int l, int) {
    const int t = (int)(gid / PQW), n = (int)(gid % PQW);
    const bf16_t* a = p.h + (size_t)t * D_MODEL; const float* w = p.peer_wq + (size_t)l * D_MODEL * PQW + n; float acc = 0.f;
    for (int k = 0; k < D_MODEL; ++k) acc += bf2f(a[k]) * w[(size_t)k * PQW];
    p.bufA[gid] = f2bf(acc);
}
HD void nv_even_a(long gid, const P& p, int l, int) {
    const int t = (int)(gid / MIX_W), c = (int)(gid % MIX_W), pos = tok_pos(t), len = tok_len(t);
    const float* cw = p.a_conv_w + (size_t)(l / 2) * A_CONV * MIX_W; float acc = 0.f;
    for (int j = 0; j < A_CONV; ++j) { const int q = pos + j - A_CONV / 2; if (q < 0 || q >= len) continue;
        const bf16_t* r = p.bufA + (size_t)(t + q - pos) * IN_W; acc += cw[j * MIX_W + c] * bf2f(r[MIX_W + c]) * bf2f(r[c]); }
    p.h[(size_t)t * (2 * MIX_W) + c] = f2bf(bf2f(p.bufA[(size_t)t * IN_W + 2 * MIX_W + c]) * acc);
}
HD void nv_even_vn(long gid, const P& p, int, int) {
    const bf16_t* r = p.bufA + (size_t)gid * IN_W + 4 * MIX_W; float s = 0.f;
    for (int i = 0; i < MIX_W; ++i) { const float g = gelu_f(bf2f(r[i])); s += g * g; }
    p.rstd[gid] = 1.0f / sqrtf(s / MIX_W + EPS);
}
HD void nv_even_b(long gid, const P& p, int l, int) {
    const int t = (int)(gid / MIX_W), c = (int)(gid % MIX_W), pos = tok_pos(t), pp = pos % CHUNK, tb = t - pp, g = c / BGC;
    const float* ws = p.b_spatial_w + ((size_t)(l / 2) * B_GROUPS + g) * CHUNK * CHUNK + (size_t)pp * CHUNK;
    const float vg = p.b_vnorm_g[(l / 2) * MIX_W + c];
    float s = p.b_spatial_b[((size_t)(l / 2) * B_GROUPS + g) * CHUNK + pp];
    for (int q = 0; q < CHUNK; ++q) s += ws[q] * gelu_f(bf2f(p.bufA[(size_t)(tb + q) * IN_W + 4 * MIX_W + c])) * p.rstd[tb + q] * vg;
    p.h[(size_t)t * (2 * MIX_W) + MIX_W + c] = f2bf(gelu_f(bf2f(p.bufA[(size_t)t * IN_W + 3 * MIX_W + c])) * s);
}
HD void nv_odd_conv(long gid, const P& p, int l, int) {
    const int t = (int)(gid / MIX_W), c = (int)(gid % MIX_W), pos = tok_pos(t), len = tok_len(t);
    const float* cw = p.c_conv_w + (size_t)(l / 2) * C_CONV * MIX_W; float acc = p.c_conv_b[(l / 2) * MIX_W + c];
    for (int j = 0; j < C_CONV; ++j) { const int q = pos + j - C_CONV / 2; if (q < 0 || q >= len) continue;
        const bf16_t* r = p.bufA + (size_t)(t + q - pos) * IN_W; acc += cw[j * MIX_W + c] * bf2f(r[c]) * sigmoid_f(bf2f(r[MIX_W + c])); }
    p.bufB[gid] = acc;
}
HD void nv_odd_cnorm(long gid, const P& p, int l, int) {
    const float* r = p.bufB + (size_t)gid * MIX_W; bf16_t* o = p.h + (size_t)gid * (2 * MIX_W); float s = 0.f;
    for (int i = 0; i < MIX_W; ++i) s += r[i] * r[i];
    const float rs = 1.0f / sqrtf(s / MIX_W + EPS);
    for (int i = 0; i < MIX_W; ++i) o[i] = f2bf(silu_f(r[i] * rs * p.c_norm_g[(l / 2) * MIX_W + i]));
}
HD void nv_odd_qk(long gid, const P& p, int l, int) {
    const int m = (int)(gid % 2), hh = (int)((gid / 2) % D_HEADS), which = (int)((gid / (2 * D_HEADS)) % 2), t = (int)(gid / (4 * D_HEADS));
    bf16_t* r = p.bufA + (size_t)t * IN_W + (2 + which) * MIX_W + hh * 2 * D_HEAD_DIM + m * D_HEAD_DIM;
    const float* g = p.d_qk_norm_g + ((size_t)(l / 2) * 2 + which) * D_HEAD_DIM;
    float s = 0.f;
    for (int i = 0; i < D_HEAD_DIM; ++i) { const float v = bf2f(r[i]); s += v * v; }
    const float rs = 1.0f / sqrtf(s / D_HEAD_DIM + EPS);
    if (t < NLAT) {
        const int pos = tok_pos(t); const float row = (float)(pos / GRID_W), col = (float)(pos % GRID_W); const int nf = D_HEAD_DIM / 4;
        for (int i = 0; i < D_HEAD_DIM / 2; ++i) {
            const int fi = i < nf ? i : i - nf; const float inv = powf(ROPE_THETA, -(float)fi / (float)nf); const float ang = (i < nf ? row : col) * inv;
            const float cs = cosf(ang), sn = sinf(ang); const float t1 = bf2f(r[2 * i]) * rs * g[2 * i], t2 = bf2f(r[2 * i + 1]) * rs * g[2 * i + 1];
            r[2 * i] = f2bf(t1 * cs - t2 * sn); r[2 * i + 1] = f2bf(t1 * sn + t2 * cs); }
    } else { for (int i = 0; i < D_HEAD_DIM; ++i) r[i] = f2bf(bf2f(r[i]) * rs * g[i]); }
}
HD int kv_tok(int b, int kk) { return kk < CTX_LEN ? NLAT + b * CTX_LEN + kk : b * SEQ + (kk - CTX_LEN); }
HD void nv_attn_s(long gid, const P& p, int, int b) {
    const int kk = (int)(gid % LKV), q = (int)((gid / LKV) % SEQ), m = (int)((gid / ((long)LKV * SEQ)) % 2), hh = (int)(gid / ((long)LKV * SEQ * 2));
    const bf16_t* qr = p.bufA + (size_t)(b * SEQ + q) * IN_W + 2 * MIX_W + hh * 2 * D_HEAD_DIM + m * D_HEAD_DIM;
    const bf16_t* kr = p.bufA + (size_t)kv_tok(b, kk) * IN_W + 3 * MIX_W + hh * 2 * D_HEAD_DIM + m * D_HEAD_DIM;
    float s = 0.f;
    for (int i = 0; i < D_HEAD_DIM; ++i) s += bf2f(qr[i]) * bf2f(kr[i]);
    p.bufB[gid] = s * (1.0f / sqrtf((float)D_HEAD_DIM));
}
HD float lam_init_f(int l) { return 0.8f - 0.6f * expf(-0.3f * (float)l); }
HD float lam_val(const P& p, int l) {
    const float* lp = p.d_lambda + (size_t)(l / 2) * 4 * D_HEAD_DIM; float s0 = 0.f, s1 = 0.f;
    for (int i = 0; i < D_HEAD_DIM; ++i) { s0 += lp[i] * lp[D_HEAD_DIM + i]; s1 += lp[2 * D_HEAD_DIM + i] * lp[3 * D_HEAD_DIM + i]; }
    return expf(s0) - expf(s1) + lam_init_f(l);
}
HD void nv_attn_sm(long gid, const P& p, int l, int) {
    const int q = (int)(gid % SEQ), hh = (int)(gid / SEQ);
    float* s0 = p.bufB + ((size_t)(hh * 2 + 0) * SEQ + q) * LKV; float* s1 = p.bufB + ((size_t)(hh * 2 + 1) * SEQ + q) * LKV;
    float m0 = -1e30f, m1 = -1e30f;
    for (int k = 0; k < LKV; ++k) { m0 = fmaxf(m0, s0[k]); m1 = fmaxf(m1, s1[k]); }
    float l0 = 0.f, l1 = 0.f;
    for (int k = 0; k < LKV; ++k) { l0 += expf(s0[k] - m0); l1 += expf(s1[k] - m1); }
    const float lam = lam_val(p, l);
    for (int k = 0; k < LKV; ++k) s0[k] = expf(s0[k] - m0) / l0 - lam * expf(s1[k] - m1) / l1;
}
HD void nv_attn_pv(long gid, const P& p, int, int b) {
    const int e = (int)(gid % (2 * D_HEAD_DIM)), hh = (int)((gid / (2 * D_HEAD_DIM)) % D_HEADS), q = (int)(gid / (2 * D_HEAD_DIM * D_HEADS));
    const float* a = p.bufB + ((size_t)(hh * 2) * SEQ + q) * LKV; float acc = 0.f;
    for (int kk = 0; kk < LKV; ++kk) acc += a[kk] * bf2f(p.bufA[(size_t)kv_tok(b, kk) * IN_W + 4 * MIX_W + hh * 2 * D_HEAD_DIM + e]);
    p.bufB[((size_t)(hh * 2 + 1) * SEQ + q) * LKV + e] = acc;
}
HD void nv_attn_subln(long gid, const P& p, int l, int b) {
    const int hh = (int)(gid % D_HEADS), q = (int)(gid / D_HEADS);
    const float* r = p.bufB + ((size_t)(hh * 2 + 1) * SEQ + q) * LKV; bf16_t* o = p.h + (size_t)(b * SEQ + q) * (2 * MIX_W) + MIX_W + hh * 2 * D_HEAD_DIM; float s = 0.f;
    for (int i = 0; i < 2 * D_HEAD_DIM; ++i) s += r[i] * r[i];
    const float rs = 1.0f / sqrtf(s / (2 * D_HEAD_DIM) + EPS), li = lam_init_f(l);
    for (int i = 0; i < 2 * D_HEAD_DIM; ++i) o[i] = f2bf(r[i] * rs * p.d_subln_g[(l / 2) * 2 * D_HEAD_DIM + i] * (1.0f - li));
}
HD void nv_peer_s(long gid, const P& p, int l, int) {
    const int k = (int)(gid % PEER_KEYS), pp = (int)((gid / PEER_KEYS) % 2), hh = (int)((gid / (2 * PEER_KEYS)) % PEER_HEADS), t = (int)(gid / (2 * PEER_KEYS * PEER_HEADS));
    const bf16_t* q = p.bufA + (size_t)t * PQW + hh * PEER_QDIM + pp * (PEER_QDIM / 2);
    const float* sk = p.peer_subkeys + ((((size_t)l * PEER_HEADS + hh) * 2 + pp) * PEER_KEYS + k) * (PEER_QDIM / 2); float s = 0.f;
    for (int i = 0; i < PEER_QDIM / 2; ++i) s += bf2f(q[i]) * sk[i];
    p.bufB[gid] = s;
}
HD void nv_peer_top1(long gid, const P& p, int, int) {
    const float* s = p.bufB + (size_t)gid * PEER_KEYS; float* sv = p.sv + (size_t)gid * PEER_TOPK; int* si = p.si + (size_t)gid * PEER_TOPK;
    float pv = 3.0e38f; int pi = -1;
    for (int r = 0; r < PEER_TOPK; ++r) { float bv = -3.0e38f; int bi = -1;
        for (int k = 0; k < PEER_KEYS; ++k) { const float v = s[k]; const bool elig = v < pv || (v == pv && k > pi); if (elig && (bi < 0 || v > bv)) { bv = v; bi = k; } }
        if (bi < 0) { bi = 0; bv = 0.f; } sv[r] = bv; si[r] = bi; pv = bv; pi = bi; }
}
HD void nv_peer_top2(long gid, const P& p, int, int) {
    const float* sv0 = p.sv + (size_t)gid * 2 * PEER_TOPK; const float* sv1 = sv0 + PEER_TOPK;
    const int* si0 = p.si + (size_t)gid * 2 * PEER_TOPK; const int* si1 = si0 + PEER_TOPK;
    int* idx = p.pidx + (size_t)gid * PEER_TOPK; float* g = p.pg + (size_t)gid * PEER_TOPK;
    float pv = 3.0e38f; int pi = -1; float c0 = 0.f, sum = 0.f;
    for (int r = 0; r < PEER_TOPK; ++r) { float bv = -3.0e38f; int bi = -1;
        for (int k = 0; k < PEER_TOPK * PEER_TOPK; ++k) { const float v = sv0[k / PEER_TOPK] + sv1[k % PEER_TOPK]; const bool elig = v < pv || (v == pv && k > pi); if (elig && (bi < 0 || v > bv)) { bv = v; bi = k; } }
        if (bi < 0) { bi = 0; bv = 0.f; } idx[r] = si0[bi / PEER_TOPK] * PEER_KEYS + si1[bi % PEER_TOPK]; g[r] = bv; pv = bv; pi = bi;
        if (r == 0) c0 = bv; sum += expf(bv - c0); }
    for (int r = 0; r < PEER_TOPK; ++r) g[r] = expf(g[r] - c0) / sum;
}
HD void nv_peer_act(long gid, const P& p, int l, int) {
    const int t = (int)(gid / NPAIR); const int e = p.pidx[gid];
    const bf16_t* a = p.h + (size_t)t * D_MODEL; const float* u = p.peer_u + ((size_t)l * PEER_EXPERTS + e) * D_MODEL; float s = 0.f;
    for (int i = 0; i < D_MODEL; ++i) s += bf2f(a[i]) * u[i];
    p.pw[gid] = p.pg[gid] * gelu_f(s);
}
HD void nv_peer_out(long gid, const P& p, int l, int) {
    const int t = (int)(gid / D_MODEL), d = (int)(gid % D_MODEL);
    const int* idx = p.pidx + (size_t)t * NPAIR; const float* w = p.pw + (size_t)t * NPAIR; float acc = 0.f;
    for (int j = 0; j < NPAIR; ++j) acc += w[j] * p.peer_v[((size_t)l * PEER_EXPERTS + idx[j]) * D_MODEL + d];
    p.xcur[gid] += ada_ptr(p, l, t, 5)[d] * acc;
}

typedef void (*nv_body_t)(long, const P&, int, int);

template <class R> HD void naive_forward(R& r, const P& p) {
    r.prologue();
    r.norm_first();
    for (int l = 0; l < DEPTH; ++l) {
        const bool last = l == DEPTH - 1;
        const long nt2 = last ? NLAT : NT;
        r.gemm_in(l);
        if (l % 2 == 0) r.even_mixer(l);
        else { r.odd_conformer(l); r.odd_attention(l); }
        r.gemm_out(l, nt2);
        r.norm2(l, nt2);
        r.gemm_q(l, nt2);
        r.peer_topk(l, nt2);
        r.peer_gather(l, nt2);
    }
}
template <class R> HD void naive_prologue(R& r) { r.template run<nv_ada>((long)DEPTH * (BATCH + 1) * N_ADA * D_MODEL, 0, 0); }
template <class R> HD void naive_norm_first(R& r) {
    r.template run<nv_copy_in>((long)NT * D_MODEL, 0, 0); r.template run<nv_rstd>(NT, 0, 0); r.template run<nv_mod>((long)NT * D_MODEL, 0, 0); }
template <class R> HD void naive_even_mixer(R& r, int l) {
    r.template run<nv_even_a>((long)NT * MIX_W, l, 0); r.template run<nv_even_vn>(NT, l, 0); r.template run<nv_even_b>((long)NT * MIX_W, l, 0); }
template <class R> HD void naive_odd_conformer(R& r, int l) { r.template run<nv_odd_conv>((long)NLAT * MIX_W, l, 0); r.template run<nv_odd_cnorm>(NLAT, l, 0); }
template <class R> HD void naive_norm2(R& r, int l, long nt2) { r.template run<nv_rstd>(nt2, l, 0); r.template run<nv_mod>(nt2 * D_MODEL, l, 1); }
template <class R> HD void naive_odd_attention(R& r, int l) {
    r.template run<nv_odd_qk>((long)NT * 4 * D_HEADS, l, 0);
    for (int b = 0; b < BATCH; ++b) {
        r.template run<nv_attn_s>((long)D_HEADS * 2 * SEQ * LKV, l, b);
        r.template run<nv_attn_sm>((long)D_HEADS * SEQ, l, b);
        r.template run<nv_attn_pv>((long)SEQ * D_HEADS * 2 * D_HEAD_DIM, l, b);
        r.template run<nv_attn_subln>((long)SEQ * D_HEADS, l, b);
    }
}
template <class R> HD void naive_peer_topk(R& r, int l, long nt2) {
    r.template run<nv_peer_s>(nt2 * PEER_HEADS * 2 * PEER_KEYS, l, 0);
    r.template run<nv_peer_top1>(nt2 * PEER_HEADS * 2, l, 0);
    r.template run<nv_peer_top2>(nt2 * PEER_HEADS, l, 0);
}
template <class R> HD void naive_peer_gather(R& r, int l, long nt2) {
    r.template run<nv_peer_act>(nt2 * NPAIR, l, 0);
    r.template run<nv_peer_out>(nt2 * D_MODEL, l, 0);
    if (l == DEPTH - 1) { r.template run<nv_copy_out>((long)NLAT * D_MODEL, 0, 0); }
    else { r.template run<nv_rstd>(NT, l + 1, 0); r.template run<nv_mod>((long)NT * D_MODEL, l + 1, 0); }
}

static size_t align_up(size_t v) { return (v + 255) & ~(size_t)255; }
static size_t max_sz(size_t a, size_t b) { return a > b ? a : b; }

static size_t carve_ws(P& p, char* ws) {
    size_t off = 0;
    p.bar = (unsigned*)(ws + off); off += align_up((size_t)BAR_ALLOC_WORDS * 4);
    p.ada = (float*)(ws + off); off += align_up((size_t)DEPTH * (BATCH + 1) * N_ADA * D_MODEL * 4);
    p.rstd = (float*)(ws + off); off += align_up((size_t)NT * 4);
    p.xcur = (float*)(ws + off); off += align_up((size_t)NT * D_MODEL * 4);
    p.xb = (bf16_t*)p.xcur;
    p.h = (bf16_t*)(ws + off); off += align_up((size_t)NT * D_MODEL * 2);
    p.bufA = (bf16_t*)(ws + off); off += align_up((size_t)NT * IN_W * 2);
    p.sv = (float*)p.bufA; p.si = (int*)(p.sv + (size_t)NT * PEER_HEADS * 2 * PEER_TOPK);
    p.pidx = (int*)(ws + off); off += align_up((size_t)NT * NPAIR * 4);
    p.pg = (float*)(ws + off); off += align_up((size_t)NT * NPAIR * 4);
    p.bufB = (float*)(ws + off); off += align_up(max_sz((size_t)NT * PQW, (size_t)D_HEADS * 2 * SEQ * LKV) * 4);
    p.pw = p.bufB;
    p.qp = (bf16_t*)p.bufB; p.kp = p.qp + (size_t)BATCH * D_HEADS * 2 * SEQ * D_HEAD_DIM; p.vt = p.kp + (size_t)BATCH * D_HEADS * 2 * LKV * D_HEAD_DIM;
    p.wt_in = (bf16_t*)(ws + off); off += align_up((size_t)DEPTH * IN_W * D_MODEL * 2);
    p.wt_out = (bf16_t*)(ws + off); off += align_up((size_t)DEPTH * D_MODEL * 2 * MIX_W * 2);
    p.wt_q = (bf16_t*)(ws + off); off += align_up((size_t)DEPTH * PQW * D_MODEL * 2);
    p.u8 = (unsigned char*)(ws + off); off += align_up((size_t)DEPTH * PEER_EXPERTS * D_MODEL);
    p.v8 = (unsigned char*)(ws + off); off += align_up((size_t)DEPTH * PEER_EXPERTS * D_MODEL);
    p.su = (float*)(ws + off); off += align_up((size_t)DEPTH * PEER_EXPERTS * 4);
    p.svs = (float*)(ws + off); off += align_up((size_t)DEPTH * PEER_EXPERTS * 4);
    p.rope = (float*)(ws + off); off += align_up((size_t)SEQ * D_HEAD_DIM * 4);
    p.pidx16 = (unsigned short*)(ws + off); off += align_up((size_t)NT * NPAIR * 2);
    p.hq = (unsigned char*)(ws + off); off += align_up((size_t)NT * D_MODEL);
    p.sh = (float*)(ws + off); off += align_up((size_t)NT * 4);
    p.vss = (float*)(ws + off); off += align_up((size_t)NT * 8 * 4);
    p.wsb = (bf16_t*)(ws + off); off += align_up((size_t)((DEPTH + 1) / 2) * B_GROUPS * CHUNK * CHUNK * 2);
    return off;
}

#ifndef HOST_TEST
#define LAS __attribute__((address_space(3)))
#define NTHREADS 512
#define LDS_BYTES 147456
__device__ __forceinline__ int tid_opaque() { int t = threadIdx.x; asm volatile("" : "+v"(t)); return t; }

#define XB_TMO      128
#define XB_XCNT(j)  (256  + 64 * (j))
#define XB_XSUB(j)  (1280 + 64 * (j))
#define XB_XGEN(j)  (2304 + 64 * (j))
#define XB_TOP      3328
#define XB_TOPGEN   3392
#define XB_SPIN_CAP (1u << 24)
__device__ __forceinline__ unsigned xb_ld(unsigned* p)              { return __hip_atomic_load(p, __ATOMIC_RELAXED, __HIP_MEMORY_SCOPE_AGENT); }
__device__ __forceinline__ unsigned xb_add(unsigned* p, unsigned v) { return __hip_atomic_fetch_add(p, v, __ATOMIC_RELAXED, __HIP_MEMORY_SCOPE_AGENT); }
__device__ __forceinline__ unsigned xb_xcc_id() { return (unsigned)__builtin_amdgcn_s_getreg((3 << 11) | 20) & 0xFu; }
#define XB_SPIN(cond, bar) do { unsigned _sp = 0; while (cond) { __builtin_amdgcn_s_sleep(1); \
    if ((++_sp & 255u) == 0u) { if (xb_ld(&(bar)[XB_TMO])) break; if (_sp > XB_SPIN_CAP) { atomicAdd(&(bar)[XB_TMO], 1u); break; } } } } while (0)
struct XcdBarrier { unsigned* bar; unsigned x; volatile LAS unsigned* st; };
__device__ __forceinline__ XcdBarrier xcd_barrier_post(unsigned* bar, volatile LAS unsigned* st) {
    XcdBarrier b; b.bar = bar; b.x = xb_xcc_id(); b.st = st;
    if (threadIdx.x == 0) (void)xb_add(&bar[XB_XCNT(b.x)], 1u);
    return b;
}
__device__ __forceinline__ void xcd_barrier_complete(unsigned* bar, unsigned x, unsigned& nloc, unsigned& nx) {
    const unsigned G = gridDim.x * gridDim.y * gridDim.z;
    unsigned sum, cnt, mine, sp = 0u;
    for (;;) {
        sum = 0u; cnt = 0u; mine = 0u;
#pragma unroll
        for (unsigned j = 0; j < 16; ++j) { const unsigned c = xb_ld(&bar[XB_XCNT(j)]); sum += c; cnt += (c > 0u) ? 1u : 0u; mine = (j == x) ? c : mine; }
        if (sum == G) break;
        __builtin_amdgcn_s_sleep(1);
        if ((++sp & 255u) == 0u) { if (xb_ld(&bar[XB_TMO])) break; if (sp > XB_SPIN_CAP) { atomicAdd(&bar[XB_TMO], 1u); break; } }
    }
    nloc = mine > 0u ? mine : 1u; nx = cnt > 0u ? cnt : 1u;
}
__device__ __forceinline__ void xcd_barrier(const XcdBarrier& b) {
    asm volatile("s_waitcnt vmcnt(0)" ::: "memory");
    __syncthreads();
    if (threadIdx.x == 0) {
        unsigned* bar = b.bar;
        __builtin_amdgcn_s_waitcnt(0);
        unsigned nloc = b.st[0], nx = b.st[1];
        if (nloc == 0u) { xcd_barrier_complete(bar, b.x, nloc, nx); b.st[0] = nloc; b.st[1] = nx; }
        const unsigned old = xb_add(&bar[XB_XSUB(b.x)], 1u);
        const unsigned gen = old / nloc;
        if (old + 1u == (gen + 1u) * nloc) {
            __builtin_amdgcn_fence(__ATOMIC_RELEASE, "agent");
            asm volatile("s_waitcnt vmcnt(0)" ::: "memory");
            const unsigned og = xb_add(&bar[XB_TOP], 1u);
            const unsigned tg = og / nx;
            if (og + 1u == (tg + 1u) * nx) xb_add(&bar[XB_TOPGEN], 1u);
            else XB_SPIN(xb_ld(&bar[XB_TOPGEN]) == tg, bar);
            __builtin_amdgcn_fence(__ATOMIC_ACQUIRE, "agent");
            xb_add(&bar[XB_XGEN(b.x)], 1u);
            asm volatile("s_waitcnt vmcnt(0)" ::: "memory");
        } else {
            XB_SPIN(xb_ld(&bar[XB_XGEN(b.x)]) == gen, bar);
            __builtin_amdgcn_fence(__ATOMIC_ACQUIRE, "agent");
            asm volatile("s_waitcnt vmcnt(0)" ::: "memory");
        }
    }
    __syncthreads();
}


typedef short bf16x8 __attribute__((ext_vector_type(8)));
typedef float f32x4 __attribute__((ext_vector_type(4)));
typedef unsigned u32x4 __attribute__((ext_vector_type(4)));
typedef unsigned u32x2 __attribute__((ext_vector_type(2)));
typedef __bf16 bf16x2_t __attribute__((ext_vector_type(2)));
__device__ __forceinline__ unsigned pk_bf16(float lo, float hi) { bf16x2_t v; v[0] = (__bf16)lo; v[1] = (__bf16)hi; return __builtin_bit_cast(unsigned, v); }
__device__ __forceinline__ u32x2 quad_gather16(unsigned w0, unsigned w1, unsigned w2, unsigned w3, int lane) {
    unsigned A = (w0 & 0xffffu) | (w1 << 16), B = (w2 & 0xffffu) | (w3 << 16);
    const unsigned sel1 = (lane & 1) ? 0x03020706u : 0x05040100u;
    const unsigned tA = (unsigned)__builtin_amdgcn_update_dpp(0, (int)A, 0xB1, 0xF, 0xF, true), tB = (unsigned)__builtin_amdgcn_update_dpp(0, (int)B, 0xB1, 0xF, 0xF, true);
    A = __builtin_amdgcn_perm(tA, A, sel1); B = __builtin_amdgcn_perm(tB, B, sel1);
    const bool b1 = lane & 2;
    const unsigned keep = b1 ? B : A, send = b1 ? A : B;
    const unsigned recv = (unsigned)__builtin_amdgcn_update_dpp(0, (int)send, 0x4E, 0xF, 0xF, true);
    u32x2 o; o.x = b1 ? recv : keep; o.y = b1 ? keep : recv; return o;
}
#define WRED_DPP(v, ctrl) __int_as_float(__builtin_amdgcn_update_dpp(0, __float_as_int(v), ctrl, 0xF, 0xF, true))
__device__ __forceinline__ float wave_sum_fast(float v) {
    v += WRED_DPP(v, 0xB1); v += WRED_DPP(v, 0x4E); v += WRED_DPP(v, 0x141); v += WRED_DPP(v, 0x140);
    { auto rr = __builtin_amdgcn_permlane16_swap(__float_as_uint(v), __float_as_uint(v), false, false); v = __uint_as_float(rr[0]) + __uint_as_float(rr[1]); }
    { auto rr = __builtin_amdgcn_permlane32_swap(__float_as_uint(v), __float_as_uint(v), false, false); v = __uint_as_float(rr[0]) + __uint_as_float(rr[1]); }
    return v; }
__device__ __forceinline__ float wave_max_fast(float v) {
    v = fmaxf(v, WRED_DPP(v, 0xB1)); v = fmaxf(v, WRED_DPP(v, 0x4E)); v = fmaxf(v, WRED_DPP(v, 0x141)); v = fmaxf(v, WRED_DPP(v, 0x140));
    { auto rr = __builtin_amdgcn_permlane16_swap(__float_as_uint(v), __float_as_uint(v), false, false); v = fmaxf(__uint_as_float(rr[0]), __uint_as_float(rr[1])); }
    { auto rr = __builtin_amdgcn_permlane32_swap(__float_as_uint(v), __float_as_uint(v), false, false); v = fmaxf(__uint_as_float(rr[0]), __uint_as_float(rr[1])); }
    return v; }

__device__ __forceinline__ void transpose_item(const float* W, int K, int N, bf16_t* WT, LAS float* scr, int item, int lane) {
    const int nblk = N / 32, kb = item / nblk, nb = item % nblk, k0 = 64 * kb, n0 = 32 * nb;
    f32x4 v[8];
#pragma unroll
    for (int i = 0; i < 8; ++i) v[i] = *(const f32x4*)(W + (size_t)(k0 + 8 * i + (lane >> 3)) * N + n0 + 4 * (lane & 7));
#pragma unroll
    for (int i = 0; i < 8; ++i) { LAS float* d = scr + (8 * i + (lane >> 3)) * 33 + 4 * (lane & 7); d[0] = v[i][0]; d[1] = v[i][1]; d[2] = v[i][2]; d[3] = v[i][3]; }
    asm volatile("s_waitcnt lgkmcnt(0)" ::: "memory");
    const int c = lane & 7;
#pragma unroll
    for (int j = 0; j < 4; ++j) { const int n = (lane >> 3) + 8 * j; const LAS float* s = scr + (8 * c) * 33 + n;
        u32x4 o; o.x = pk_bf16(s[0 * 33], s[1 * 33]); o.y = pk_bf16(s[2 * 33], s[3 * 33]); o.z = pk_bf16(s[4 * 33], s[5 * 33]); o.w = pk_bf16(s[6 * 33], s[7 * 33]);
        *(u32x4*)(WT + (size_t)(n0 + n) * K + k0 + 8 * c) = o; }
    asm volatile("s_waitcnt lgkmcnt(0)" ::: "memory");
}
__device__ __forceinline__ void phase_weights(const P& p, LAS unsigned char* lds) {
    const int tid = tid_opaque(); const int lane = tid & 63, wave = tid >> 6;
    LAS float* scr = (LAS float*)(lds + 1024 + wave * 8704);
    const int gw = blockIdx.x * (NTHREADS / 64) + wave, ngw = gridDim.x * (NTHREADS / 64);
    constexpr int I_IN = (D_MODEL / 64) * (IN_W / 32), I_OUT = (2 * MIX_W / 64) * (D_MODEL / 32), I_Q = (D_MODEL / 64) * (PQW / 32);
    constexpr int PER_L = I_IN + I_OUT + I_Q;
    for (int it = gw; it < DEPTH * PER_L; it += ngw) {
        const int l = it / PER_L; int r = it % PER_L;
        if (r < I_IN) { transpose_item(p.w_in + (size_t)l * D_MODEL * IN_W, D_MODEL, IN_W, p.wt_in + (size_t)l * IN_W * D_MODEL, scr, r, lane); continue; } r -= I_IN;
        if (r < I_OUT) { transpose_item(p.w_out + (size_t)l * 2 * MIX_W * D_MODEL, 2 * MIX_W, D_MODEL, p.wt_out + (size_t)l * D_MODEL * 2 * MIX_W, scr, r, lane); continue; } r -= I_OUT;
        transpose_item(p.peer_wq + (size_t)l * D_MODEL * PQW, D_MODEL, PQW, p.wt_q + (size_t)l * PQW * D_MODEL, scr, r, lane);
    }
}

#define G_BM 256
#define G_BN 128
#define G_BK 64
#define G_STAGE (G_BM * 128 + G_BN * 128)
#define G_LDS0 1024
struct GemmDesc { const bf16_t* A; const bf16_t* Bt; int K, ntm_full, ntm_tot, ntn, part_pn_lo; };
template <class Epi> __device__ __forceinline__ void gemm_phase(LAS unsigned char* lds0, const GemmDesc g, const Epi& E) {
    LAS unsigned char* lds = lds0 + G_LDS0;
    const int tid = tid_opaque(), lane = tid & 63, wid = tid >> 6, wm = wid >> 1, wn = wid & 1, fr = lane & 15, fq = lane >> 4;
    const int nxg = (gridDim.x % 8 == 0) ? 8 : 1, xg = blockIdx.x % nxg, jb = blockIdx.x / nxg, nj = gridDim.x / nxg;
    const int a_full = g.ntm_full > xg ? (g.ntm_full - xg + nxg - 1) / nxg : 0, a_tot = g.ntm_tot > xg ? (g.ntm_tot - xg + nxg - 1) / nxg : 0;
    const int nc = g.ntn - g.part_pn_lo, n_local = a_full * g.ntn + (a_tot - a_full) * nc;
    const int K = g.K, nk = K / G_BK;
    const int srow = tid >> 3, sch = tid & 7;
    const int sw = (fr >> 1) & 7, c0 = fq ^ sw;
    const int a_rd = (wm * 64 + fr) * 128, b_rd = G_BM * 128 + (wn * 64 + fr) * 128;
    for (int u = jb; u < n_local; u += nj) {
        int a, pn;
        if (u < a_full * g.ntn) { a = u / g.ntn; pn = u % g.ntn; } else { const int u2 = u - a_full * g.ntn; a = a_full + u2 / nc; pn = g.part_pn_lo + u2 % nc; }
        const int pm = xg + nxg * a;
        const bf16_t* Ag = g.A + ((size_t)pm * G_BM + srow) * K + sch * 8;
        const bf16_t* Bg = g.Bt + ((size_t)pn * G_BN + srow) * K + sch * 8;
        f32x4 acc[4][4];
#pragma unroll
        for (int i = 0; i < 4; ++i)
#pragma unroll
            for (int j = 0; j < 4; ++j) acc[i][j] = (f32x4){0.f, 0.f, 0.f, 0.f};
        u32x4 ra[4], rb[2];
#pragma unroll
        for (int i = 0; i < 4; ++i) ra[i] = *(const u32x4*)(Ag + (size_t)(i * 64) * K);
#pragma unroll
        for (int i = 0; i < 2; ++i) rb[i] = *(const u32x4*)(Bg + (size_t)(i * 64) * K);
#pragma unroll
        for (int i = 0; i < 4; ++i) { const int row = srow + i * 64; *(LAS u32x4*)(lds + row * 128 + ((sch ^ ((row >> 1) & 7)) << 4)) = ra[i]; }
#pragma unroll
        for (int i = 0; i < 2; ++i) { const int row = srow + i * 64; *(LAS u32x4*)(lds + G_BM * 128 + row * 128 + ((sch ^ ((row >> 1) & 7)) << 4)) = rb[i]; }
        __syncthreads();
        for (int kt = 0; kt < nk; ++kt) {
            LAS unsigned char* cur = lds + (kt & 1) * G_STAGE;
            LAS unsigned char* nxt = lds + ((kt + 1) & 1) * G_STAGE;
            if (kt + 1 < nk) {
#pragma unroll
                for (int i = 0; i < 4; ++i) ra[i] = *(const u32x4*)(Ag + (size_t)(i * 64) * K + (kt + 1) * G_BK);
#pragma unroll
                for (int i = 0; i < 2; ++i) rb[i] = *(const u32x4*)(Bg + (size_t)(i * 64) * K + (kt + 1) * G_BK);
            }
#pragma unroll
            for (int kk = 0; kk < 2; ++kk) {
                bf16x8 af[4], bfr[4];
                const int co = (c0 ^ (kk * 4)) << 4;
#pragma unroll
                for (int i = 0; i < 4; ++i) af[i] = *(const LAS bf16x8*)(cur + a_rd + i * 2048 + co);
#pragma unroll
                for (int i = 0; i < 4; ++i) bfr[i] = *(const LAS bf16x8*)(cur + b_rd + i * 2048 + co);
#pragma unroll
                for (int i = 0; i < 4; ++i)
#pragma unroll
                    for (int j = 0; j < 4; ++j) acc[i][j] = __builtin_amdgcn_mfma_f32_16x16x32_bf16(bfr[j], af[i], acc[i][j], 0, 0, 0);
            }
            if (kt + 1 < nk) {
#pragma unroll
                for (int i = 0; i < 4; ++i) { const int row = srow + i * 64; *(LAS u32x4*)(nxt + row * 128 + ((sch ^ ((row >> 1) & 7)) << 4)) = ra[i]; }
#pragma unroll
                for (int i = 0; i < 2; ++i) { const int row = srow + i * 64; *(LAS u32x4*)(nxt + G_BM * 128 + row * 128 + ((sch ^ ((row >> 1) & 7)) << 4)) = rb[i]; }
            }
            __syncthreads();
        }
#pragma unroll
        for (int i = 0; i < 4; ++i)
#pragma unroll
            for (int j = 0; j < 4; ++j) E.store(pm * G_BM + wm * 64 + i * 16 + fr, pn * G_BN + wn * 64 + j * 16 + 4 * fq, acc[i][j]);
    }
}
struct EpiBf16 { bf16_t* C; int ldc;
    __device__ __forceinline__ void store(int m, int n, f32x4 v) const { uint2 o; o.x = pk_bf16(v[0], v[1]); o.y = pk_bf16(v[2], v[3]); *(uint2*)(C + (size_t)m * ldc + n) = o; } };
__device__ __forceinline__ float gelu_fast(float x) { const float u = 1.5957691216057308f * (x + 0.044715f * x * x * x); return x * __builtin_amdgcn_rcpf(1.0f + __expf(-u)); }
struct EpiBf16Gelu { bf16_t* C; int ldc; int gelu_from;
    __device__ __forceinline__ void store(int m, int n, f32x4 v) const {
        if (n >= gelu_from) { v[0] = gelu_fast(v[0]); v[1] = gelu_fast(v[1]); v[2] = gelu_fast(v[2]); v[3] = gelu_fast(v[3]); }
        uint2 o; o.x = pk_bf16(v[0], v[1]); o.y = pk_bf16(v[2], v[3]); *(uint2*)(C + (size_t)m * ldc + n) = o; } };
struct EpiRes { const float* Xlat; const float* Xctx; bf16_t* Xout; const float* ada; int l;
    __device__ __forceinline__ void store(int m, int n, f32x4 v) const {
        const f32x4 g = *(const f32x4*)(ada + ((size_t)(l * (BATCH + 1) + tok_adarow(m)) * N_ADA + 2) * D_MODEL + n);
        const float* xi = m < NLAT ? Xlat + (size_t)m * D_MODEL + n : Xctx + (size_t)(m - NLAT) * D_MODEL + n;
        const f32x4 o = *(const f32x4*)xi + g * v; u32x2 w; w.x = pk_bf16(o[0], o[1]); w.y = pk_bf16(o[2], o[3]);
        *(u32x2*)(Xout + (size_t)m * D_MODEL + n) = w; } };


template <int NI, class Epi> __device__ __forceinline__ void gemm_small(LAS unsigned char* lds0, const bf16_t* A, const bf16_t* Bt, int K, int m_base, int nM, int nN, const Epi& E) {
    constexpr int BN = 64 * NI, STAGE = 128 * 128 + BN * 128;
    LAS unsigned char* lds = lds0 + G_LDS0;
    const int tid = tid_opaque(), lane = tid & 63, wid = tid >> 6, wm = wid >> 2, wn = wid & 3, fr = lane & 15, fq = lane >> 4;
    const int nk = K / G_BK, srow = tid >> 3, sch = tid & 7;
    const int sw = (fr >> 1) & 7, c0 = fq ^ sw;
    const int a_rd = (wm * 64 + fr) * 128, b_rd = 128 * 128 + (wn * 16 * NI + fr) * 128;
    for (int u = blockIdx.x; u < nM * nN; u += gridDim.x) {
        const int pm = u / nN, pn = u % nN;
        const bf16_t* Ag = A + ((size_t)m_base + (size_t)pm * 128 + srow) * K + sch * 8;
        const bf16_t* Bg = Bt + ((size_t)pn * BN + srow) * K + sch * 8;
        f32x4 acc[4][NI];
#pragma unroll
        for (int i = 0; i < 4; ++i)
#pragma unroll
            for (int j = 0; j < NI; ++j) acc[i][j] = (f32x4){0.f, 0.f, 0.f, 0.f};
        u32x4 ra[2], rb[NI];
#pragma unroll
        for (int i = 0; i < 2; ++i) ra[i] = *(const u32x4*)(Ag + (size_t)(i * 64) * K);
#pragma unroll
        for (int i = 0; i < NI; ++i) rb[i] = *(const u32x4*)(Bg + (size_t)(i * 64) * K);
#pragma unroll
        for (int i = 0; i < 2; ++i) { const int row = srow + i * 64; *(LAS u32x4*)(lds + row * 128 + ((sch ^ ((row >> 1) & 7)) << 4)) = ra[i]; }
#pragma unroll
        for (int i = 0; i < NI; ++i) { const int row = srow + i * 64; *(LAS u32x4*)(lds + 128 * 128 + row * 128 + ((sch ^ ((row >> 1) & 7)) << 4)) = rb[i]; }
        __syncthreads();
        for (int kt = 0; kt < nk; ++kt) {
            LAS unsigned char* cur = lds + (kt & 1) * STAGE;
            LAS unsigned char* nxt = lds + ((kt + 1) & 1) * STAGE;
            const int ktn = kt + 1 < nk ? kt + 1 : kt;
#pragma unroll
            for (int i = 0; i < 2; ++i) ra[i] = *(const u32x4*)(Ag + (size_t)(i * 64) * K + ktn * G_BK);
#pragma unroll
            for (int i = 0; i < NI; ++i) rb[i] = *(const u32x4*)(Bg + (size_t)(i * 64) * K + ktn * G_BK);
#pragma unroll
            for (int kk = 0; kk < 2; ++kk) {
                bf16x8 af[4], bfr[NI];
                const int co = (c0 ^ (kk * 4)) << 4;
#pragma unroll
                for (int i = 0; i < 4; ++i) af[i] = *(const LAS bf16x8*)(cur + a_rd + i * 2048 + co);
#pragma unroll
                for (int j = 0; j < NI; ++j) bfr[j] = *(const LAS bf16x8*)(cur + b_rd + j * 2048 + co);
#pragma unroll
                for (int i = 0; i < 4; ++i)
#pragma unroll
                    for (int j = 0; j < NI; ++j) acc[i][j] = __builtin_amdgcn_mfma_f32_16x16x32_bf16(bfr[j], af[i], acc[i][j], 0, 0, 0);
            }
            if (kt + 1 < nk) {
#pragma unroll
                for (int i = 0; i < 2; ++i) { const int row = srow + i * 64; *(LAS u32x4*)(nxt + row * 128 + ((sch ^ ((row >> 1) & 7)) << 4)) = ra[i]; }
#pragma unroll
                for (int i = 0; i < NI; ++i) { const int row = srow + i * 64; *(LAS u32x4*)(nxt + 128 * 128 + row * 128 + ((sch ^ ((row >> 1) & 7)) << 4)) = rb[i]; }
            }
            __syncthreads();
        }
#pragma unroll
        for (int i = 0; i < 4; ++i)
#pragma unroll
            for (int j = 0; j < NI; ++j) E.store(m_base + pm * 128 + wm * 64 + i * 16 + fr, pn * BN + wn * 16 * NI + j * 16 + 4 * fq, acc[i][j]);
    }
}

namespace pg8 {
#define PG8_LAS __attribute__((address_space(3)))
constexpr int BM = 256, BK = 64, HALF = 128, HTB = HALF * BK * 2  , STAGE_BYTES = 8 * HTB;
__host__ __device__ __forceinline__ int lds_byte(int r, int c) { const int st = (r >> 4) * 2 + (c >> 5), rr = r & 15, cc = c & 31, ob = rr * 64 + cc * 2; return st * 1024 + (ob ^ (((ob >> 9) & 1) << 5)); }
__host__ __device__ __forceinline__ void stage_rc(int b, int& R, int& C) { const int st = b / 1024, sb = b % 1024, swz = sb ^ (((sb >> 9) & 1) << 5); R = (st >> 1) * 16 + swz / 64; C = (st & 1) * 32 + (swz % 64) / 2; }
__host__ __device__ __forceinline__ int perm32(int rho) { const int n = rho >> 4, i = rho & 15; return 8 * (i >> 2) + 4 * n + (i & 3); }
struct Unit { int pm, pn; };
struct Gemm { const bf16_t* A; const bf16_t* Bt; int M, N, K; };
struct XcdOrder {
    int nxg, xg, jb, nj, ntn, a_full, nc, part_lo, n_local;
    __device__ __forceinline__ void init(int ntm_full, int ntm_tot, int ntn_, int part_lo_) {
        nxg = (gridDim.x % 8 == 0) ? 8 : 1; xg = blockIdx.x % nxg; jb = blockIdx.x / nxg; nj = gridDim.x / nxg; ntn = ntn_; part_lo = part_lo_;
        a_full = ntm_full > xg ? (ntm_full - xg + nxg - 1) / nxg : 0; const int a_tot = ntm_tot > xg ? (ntm_tot - xg + nxg - 1) / nxg : 0;
        nc = ntn - part_lo; n_local = a_full * ntn + (a_tot - a_full) * nc; }
    __device__ __forceinline__ bool next(int i, Unit& u) const {
        const int x = jb + i * nj; if (x >= n_local) return false;
        int a, pn; if (x < a_full * ntn) { a = x / ntn; pn = x % ntn; } else { const int x2 = x - a_full * ntn; a = a_full + x2 / nc; pn = part_lo + x2 % nc; }
        u.pm = xg + nxg * a; u.pn = pn; return true; }
    __device__ __forceinline__ void a_ready(const Unit&) const {}
    __device__ __forceinline__ void done(const Unit&) const {}
};
struct EpiStoreBf16 { static constexpr bool PERM = true, AFTER_DRAIN = false; bf16_t* O; int ldc; int gelu_from;
    float* vss; int ss_from;
    __device__ __forceinline__ void operator()(const f32x4 (&acc)[2][2][4][2], const Unit& u, int wr, int wc, int fr, int fq) const {
        const int row0 = u.pm * BM + wr * 64 + fr, col0 = u.pn * BM + wc * 32 + 8 * fq; const bool ge = col0 >= gelu_from; const bool sq = u.pn * BM >= ss_from;
#pragma unroll
        for (int ai = 0; ai < 2; ++ai)
#pragma unroll
            for (int m = 0; m < 4; ++m) { bf16_t* rowp = O + (size_t)(row0 + ai * HALF + m * 16) * ldc + col0; float ss = 0.f;
#pragma unroll
                for (int bj = 0; bj < 2; ++bj) { f32x4 v0 = acc[ai][bj][m][0], v1 = acc[ai][bj][m][1];
                    if (ge) {
#pragma unroll
                        for (int k = 0; k < 4; ++k) { v0[k] = gelu_fast(v0[k]); v1[k] = gelu_fast(v1[k]); } }
                    ss += (v0[0] * v0[0] + v0[1] * v0[1]) + (v0[2] * v0[2] + v0[3] * v0[3]) + (v1[0] * v1[0] + v1[1] * v1[1]) + (v1[2] * v1[2] + v1[3] * v1[3]);
                    u32x4 w; w.x = pk_bf16(v0[0], v0[1]); w.y = pk_bf16(v0[2], v0[3]); w.z = pk_bf16(v1[0], v1[1]); w.w = pk_bf16(v1[2], v1[3]);
                    *(u32x4*)(rowp + bj * HALF) = w; }
                if (sq) {
                    { auto rr = __builtin_amdgcn_permlane16_swap(__float_as_uint(ss), __float_as_uint(ss), false, false); ss = __uint_as_float(rr[0]) + __uint_as_float(rr[1]); }
                    { auto rr = __builtin_amdgcn_permlane32_swap(__float_as_uint(ss), __float_as_uint(ss), false, false); ss = __uint_as_float(rr[0]) + __uint_as_float(rr[1]); }
                    if (fq == 0) vss[(size_t)(row0 + ai * HALF + m * 16) * 8 + (u.pn - ss_from / BM) * 4 + wc] = ss; } }
    } };
struct EpiResidual { static constexpr bool PERM = false, AFTER_DRAIN = false; const float* Xlat; const float* Xctx; const bf16_t* Xin16; bf16_t* Xout; const float* ada; int l;
    __device__ __forceinline__ void operator()(const f32x4 (&acc)[2][2][4][2], const Unit& u, int wr, int wc, int fr, int fq) const {
        const int col0 = u.pn * BM + wc * 32 + 4 * fq;
#pragma unroll
        for (int ai = 0; ai < 2; ++ai)
#pragma unroll
            for (int m = 0; m < 4; ++m) { const int r = u.pm * BM + ai * HALF + wr * 64 + m * 16 + fr;
                const float* gp = ada + ((size_t)(l * (BATCH + 1) + tok_adarow(r)) * N_ADA + 2) * D_MODEL + col0;
                const float* xi = r < NLAT ? Xlat + (size_t)r * D_MODEL + col0 : Xctx + (size_t)(r - NLAT) * D_MODEL + col0; bf16_t* xo = Xout + (size_t)r * D_MODEL + col0;
                const bf16_t* xi16 = Xin16 + (size_t)r * D_MODEL + col0;
#pragma unroll
                for (int bj = 0; bj < 2; ++bj)
#pragma unroll
                    for (int n = 0; n < 2; ++n) { const int o = bj * HALF + n * 16; f32x4 xv;
                        if (Xin16) { const u32x2 xw = *(const u32x2*)(xi16 + o); xv = (f32x4){__uint_as_float(xw.x << 16), __uint_as_float(xw.x & 0xffff0000u), __uint_as_float(xw.y << 16), __uint_as_float(xw.y & 0xffff0000u)}; }
                        else xv = *(const f32x4*)(xi + o);
                        const f32x4 ov = xv + *(const f32x4*)(gp + o) * acc[ai][bj][m][n]; u32x2 w; w.x = pk_bf16(ov[0], ov[1]); w.y = pk_bf16(ov[2], ov[3]);
                        *(u32x2*)(xo + o) = w; } }
    } };
template <class Epi, class Sched, bool ALIGN_EPI = false, bool SP2 = false>
__device__ __forceinline__ void gemm_phase(PG8_LAS unsigned char* lds, const Gemm g, const Sched& S, const Epi& E) {
    const int tid = tid_opaque(), wid = __builtin_amdgcn_readfirstlane(tid >> 6), lane = tid & 63, wr = wid >> 2, wc = wid & 3, fr = lane & 15, fq = lane >> 4;
    const int K = g.K, nt = K / BK;
    unsigned voffA[2], voffB[2];
#pragma unroll
    for (int i = 0; i < 2; ++i) { int R, C; stage_rc(tid * 16 + i * 8192, R, C); const int Rb = Epi::PERM ? ((R & ~31) + perm32(R & 31)) : R;
        voffA[i] = (unsigned)(R * K + C) * 2u; voffB[i] = (unsigned)(Rb * K + C) * 2u; }
    const size_t kstep = (size_t)(BK * 2);
    const size_t hstep = (size_t)HALF * K * 2;
    const size_t tstep = 2 * hstep;
    const unsigned ldsw = (unsigned)wid * 1024u;
    const int aoff = lds_byte(wr * 64 + fr, fq * 8), boff = lds_byte(wc * 32 + fr, fq * 8);
#define PG8_SA(b, h) (((b) * 2 + (h)) * HTB)
#define PG8_SB(b, h) ((4 + (b) * 2 + (h)) * HTB)
#define PG8_STAGE(bufoff, gbase, voff) do { _Pragma("unroll") for (int _i = 0; _i < 2; ++_i) \
        __builtin_amdgcn_global_load_lds((const unsigned*)((const char*)(gbase) + (voff)[_i]), (PG8_LAS unsigned*)(lds + (bufoff) + ldsw + _i * 8192), 16, 0, 0); } while (0)
#define PG8_LDA(dst, b, h) do { _Pragma("unroll") for (int m = 0; m < 4; ++m) _Pragma("unroll") for (int k = 0; k < 2; ++k) dst[m][k] = *(const PG8_LAS bf16x8*)(lds + PG8_SA(b, h) + aoff + m * 2048 + k * 1024); } while (0)
#define PG8_LDB(dst, b, h) do { _Pragma("unroll") for (int n = 0; n < 2; ++n) _Pragma("unroll") for (int k = 0; k < 2; ++k) dst[n][k] = *(const PG8_LAS bf16x8*)(lds + PG8_SB(b, h) + boff + n * 2048 + k * 1024); } while (0)
#define PG8_MMA(ai, bj, At, Bt) do { __builtin_amdgcn_s_setprio(1); _Pragma("unroll") for (int m = 0; m < 4; ++m) _Pragma("unroll") for (int n = 0; n < 2; ++n) _Pragma("unroll") for (int k = 0; k < 2; ++k) \
        acc[ai][bj][m][n] = __builtin_amdgcn_mfma_f32_16x16x32_bf16(Bt[n][k], At[m][k], acc[ai][bj][m][n], 0, 0, 0); __builtin_amdgcn_s_setprio(0); } while (0)
#define PG8_WAIT_V(n) asm volatile("s_waitcnt vmcnt(" #n ")" ::: "memory")
#define PG8_WAIT_L(n) asm volatile("s_waitcnt lgkmcnt(" #n ")" ::: "memory")
#define PG8_BAR __builtin_amdgcn_s_barrier()
#define PG8_SCHED __builtin_amdgcn_sched_barrier(0)
    Unit cur, nxt; int ui = 0;
    if (!S.next(0, cur)) return;
    f32x4 acc[2][2][4][2];
#pragma unroll
    for (int a = 0; a < 2; ++a)
#pragma unroll
        for (int b = 0; b < 2; ++b)
#pragma unroll
            for (int m = 0; m < 4; ++m)
#pragma unroll
                for (int n = 0; n < 2; ++n) acc[a][b][m][n] = (f32x4){0.f, 0.f, 0.f, 0.f};
    bf16x8 At[4][2], B0[2][2], B1[2][2];
    const char* cA = (const char*)g.A + (size_t)cur.pm * tstep; const char* cB = (const char*)g.Bt + (size_t)cur.pn * tstep;
    S.a_ready(cur);
    if constexpr (SP2) {
        PG8_STAGE(PG8_SB(0, 0), cB, voffB); PG8_STAGE(PG8_SB(0, 1), cB + hstep, voffB); PG8_STAGE(PG8_SA(0, 0), cA, voffA); PG8_STAGE(PG8_SA(0, 1), cA + hstep, voffA);
        if (wr == 1) PG8_BAR;
        PG8_WAIT_V(2); PG8_BAR;
        PG8_STAGE(PG8_SB(1, 0), cB + kstep, voffB); PG8_STAGE(PG8_SA(1, 0), cA + kstep, voffA); PG8_STAGE(PG8_SB(1, 1), cB + hstep + kstep, voffB);
        PG8_WAIT_V(6); PG8_BAR;
    } else {
        PG8_STAGE(PG8_SB(0, 0), cB, voffB); PG8_STAGE(PG8_SA(0, 0), cA, voffA); PG8_STAGE(PG8_SB(0, 1), cB + hstep, voffB); PG8_STAGE(PG8_SA(0, 1), cA + hstep, voffA);
        if (wr == 1) PG8_BAR;
        PG8_WAIT_V(4); PG8_BAR;
        PG8_STAGE(PG8_SB(1, 0), cB + kstep, voffB); PG8_STAGE(PG8_SA(1, 0), cA + kstep, voffA); PG8_STAGE(PG8_SB(1, 1), cB + hstep + kstep, voffB);
        PG8_WAIT_V(6); PG8_BAR;
    }
    for (;;) {
        const bool has_next = S.next(ui + 1, nxt);
        const char* nA = has_next ? (const char*)g.A + (size_t)nxt.pm * tstep : cA; const char* nB = has_next ? (const char*)g.Bt + (size_t)nxt.pn * tstep : cB;
        for (int t = 0; t < nt; t += 2) {
            const bool last = (t == nt - 2);
            const char* a1 = cA + (size_t)(t + 1) * kstep;
            const char* a2 = last ? nA : cA + (size_t)(t + 2) * kstep; const char* b2 = last ? nB : cB + (size_t)(t + 2) * kstep;
            const char* a3 = a2 + kstep; const char* b3 = b2 + kstep;
            if (last && has_next) S.a_ready(nxt);
            if constexpr (SP2) {
            PG8_LDB(B0, 0, 0); PG8_LDB(B1, 0, 1); PG8_SCHED; PG8_LDA(At, 0, 0); PG8_STAGE(PG8_SA(1, 1), a1 + hstep, voffA);
            PG8_WAIT_V(8); PG8_WAIT_L(0); PG8_BAR; PG8_MMA(0, 0, At, B0); PG8_MMA(0, 1, At, B1); PG8_BAR; PG8_SCHED;
            PG8_LDA(At, 0, 1); PG8_STAGE(PG8_SB(0, 0), b2, voffB); PG8_STAGE(PG8_SB(0, 1), b2 + hstep, voffB); PG8_STAGE(PG8_SA(0, 0), a2, voffA);
            PG8_WAIT_V(8); PG8_WAIT_L(0); PG8_BAR; PG8_MMA(1, 0, At, B0); PG8_MMA(1, 1, At, B1); PG8_BAR; PG8_SCHED;
            PG8_LDB(B0, 1, 0); PG8_LDB(B1, 1, 1); PG8_SCHED; PG8_LDA(At, 1, 0); PG8_STAGE(PG8_SA(0, 1), a2 + hstep, voffA);
            PG8_WAIT_V(8); PG8_WAIT_L(0); PG8_BAR; PG8_MMA(0, 0, At, B0); PG8_MMA(0, 1, At, B1); PG8_BAR; PG8_SCHED;
            PG8_LDA(At, 1, 1); PG8_STAGE(PG8_SB(1, 0), b3, voffB); PG8_STAGE(PG8_SB(1, 1), b3 + hstep, voffB); PG8_STAGE(PG8_SA(1, 0), a3, voffA);
            PG8_WAIT_V(8); PG8_WAIT_L(0); PG8_BAR; PG8_MMA(1, 0, At, B0); PG8_MMA(1, 1, At, B1); PG8_BAR; PG8_SCHED;
            } else {
            PG8_LDB(B0, 0, 0); PG8_SCHED; PG8_LDA(At, 0, 0); PG8_STAGE(PG8_SA(1, 1), a1 + hstep, voffA);
            PG8_WAIT_L(8); PG8_BAR; PG8_WAIT_L(0); PG8_MMA(0, 0, At, B0); PG8_BAR; PG8_SCHED;
            PG8_LDB(B1, 0, 1); PG8_STAGE(PG8_SB(0, 0), b2, voffB);
            PG8_BAR; PG8_WAIT_L(0); PG8_MMA(0, 1, At, B1); PG8_BAR;
            PG8_LDA(At, 0, 1); PG8_STAGE(PG8_SA(0, 0), a2, voffA);
            PG8_BAR; PG8_WAIT_L(0); PG8_MMA(1, 0, At, B0); PG8_BAR; PG8_SCHED;
            PG8_STAGE(PG8_SB(0, 1), b2 + hstep, voffB);
            PG8_WAIT_V(6); PG8_BAR; PG8_MMA(1, 1, At, B1); PG8_BAR;
            PG8_LDB(B0, 1, 0); PG8_SCHED; PG8_LDA(At, 1, 0); PG8_STAGE(PG8_SA(0, 1), a2 + hstep, voffA);
            PG8_WAIT_L(8); PG8_BAR; PG8_WAIT_L(0); PG8_MMA(0, 0, At, B0); PG8_BAR; PG8_SCHED;
            PG8_LDB(B1, 1, 1); PG8_STAGE(PG8_SB(1, 0), b3, voffB);
            PG8_BAR; PG8_WAIT_L(0); PG8_MMA(0, 1, At, B1); PG8_BAR;
            PG8_LDA(At, 1, 1); PG8_STAGE(PG8_SA(1, 0), a3, voffA);
            PG8_BAR; PG8_WAIT_L(0); PG8_MMA(1, 0, At, B0); PG8_BAR; PG8_SCHED;
            PG8_STAGE(PG8_SB(1, 1), b3 + hstep, voffB);
            PG8_WAIT_V(6); PG8_BAR; PG8_MMA(1, 1, At, B1); PG8_BAR;
            }
        }
        if constexpr (ALIGN_EPI) { if (wr == 0) PG8_BAR; }
        if constexpr (!Epi::AFTER_DRAIN) { E(acc, cur, wr, wc, fr, fq); S.done(cur); }
        if (!has_next) break;
#pragma unroll
        for (int a = 0; a < 2; ++a)
#pragma unroll
            for (int b = 0; b < 2; ++b)
#pragma unroll
                for (int m = 0; m < 4; ++m)
#pragma unroll
                    for (int n = 0; n < 2; ++n) acc[a][b][m][n] = (f32x4){0.f, 0.f, 0.f, 0.f};
        cur = nxt; cA = nA; cB = nB; ++ui;
        if constexpr (ALIGN_EPI) { if (wr == 1) PG8_BAR; }
    }
    PG8_WAIT_V(0);
    if constexpr (!ALIGN_EPI) { if (wr == 0) PG8_BAR; }
    PG8_BAR;
    if constexpr (Epi::AFTER_DRAIN) { E.fused(acc, cur, wr, wc, fr, fq, lds, wid, lane); S.done(cur); }
#undef PG8_SA
#undef PG8_SB
#undef PG8_STAGE
#undef PG8_LDA
#undef PG8_LDB
#undef PG8_MMA
#undef PG8_WAIT_V
#undef PG8_WAIT_L
#undef PG8_BAR
#undef PG8_SCHED
}
}

typedef float f32x2 __attribute__((ext_vector_type(2)));
typedef __bf16 bf16v2 __attribute__((ext_vector_type(2)));
typedef __bf16 bf16v8 __attribute__((ext_vector_type(8)));
typedef _Float16 f16v2 __attribute__((ext_vector_type(2)));
__device__ __forceinline__ float wave_max(float v) { return wave_max_fast(v); }
__device__ __forceinline__ float wave_sum(float v) { return wave_sum_fast(v); }
#define FP8_TOP 224.0f
__device__ __forceinline__ void convert_finish(const f32x4 (&v)[4], unsigned char* dst, size_t slice_stride, float* scale_out, int lane) {
    float m = 0.f;
#pragma unroll
    for (int i = 0; i < 4; ++i) m = fmaxf(m, fmaxf(fmaxf(fabsf(v[i][0]), fabsf(v[i][1])), fmaxf(fabsf(v[i][2]), fabsf(v[i][3]))));
    m = wave_max(m);
    const float inv = m > 0.f ? FP8_TOP / m : 0.f;
    u32x4 o;
#pragma unroll
    for (int i = 0; i < 4; ++i) { int w = 0; w = __builtin_amdgcn_cvt_pk_fp8_f32(v[i][0] * inv, v[i][1] * inv, w, false); w = __builtin_amdgcn_cvt_pk_fp8_f32(v[i][2] * inv, v[i][3] * inv, w, true); o[i] = (unsigned)w; }
#pragma unroll
    for (int i = 0; i < 4; ++i) *(unsigned*)(dst + (size_t)(2 * i + (lane >> 5)) * slice_stride + 4 * (lane & 31)) = o[i];
    if (lane == 0) *scale_out = m > 0.f ? m / FP8_TOP : 0.f;
}
__device__ __forceinline__ void phase_peer_tables(const P& p) {
    const int tid = tid_opaque(); const int lane = tid & 63, gw = blockIdx.x * (NTHREADS / 64) + (tid >> 6), ngw = gridDim.x * (NTHREADS / 64);
    const int R = DEPTH * PEER_EXPERTS;
    for (int r0 = gw; r0 < 2 * R; r0 += 4 * ngw) {
        f32x4 v[4][4];
#pragma unroll
        for (int k = 0; k < 4; ++k) { const int r = r0 + k * ngw; if (r < 2 * R) { const int tab = r / R, row = r % R; const float* src = (tab ? p.peer_v : p.peer_u) + (size_t)row * D_MODEL;
#pragma unroll
            for (int i = 0; i < 4; ++i) v[k][i] = ((const f32x4*)src)[i * 64 + lane]; } }
#pragma unroll
        for (int k = 0; k < 4; ++k) { const int r = r0 + k * ngw; if (r < 2 * R) { const int tab = r / R, row = r % R;
            convert_finish(v[k], (tab ? p.v8 : p.u8) + ((size_t)(row / PEER_EXPERTS) * 8 * PEER_EXPERTS + (row % PEER_EXPERTS)) * 128, (size_t)PEER_EXPERTS * 128, (tab ? p.svs : p.su) + row, lane); } }
    }
}
__device__ __forceinline__ float gelu_dev(float x) { return 0.5f * x * (1.0f + tanhf(0.7978845608028654f * (x + 0.044715f * x * x * x))); }
#define PG_B 16
__device__ __forceinline__ void phase_peer_gather(const P& p, int l, int ntok, bool dry = false) {
    const int tid = tid_opaque(); const int lane = tid & 63, gw = blockIdx.x * (NTHREADS / 64) + (tid >> 6), ngw = gridDim.x * (NTHREADS / 64);
    const unsigned char* U = p.u8 + (size_t)l * PEER_EXPERTS * D_MODEL + lane * 16;
    const unsigned char* V = p.v8 + (size_t)l * PEER_EXPERTS * D_MODEL + lane * 16;
    const float* su = p.su + (size_t)l * PEER_EXPERTS; const float* svs = p.svs + (size_t)l * PEER_EXPERTS;
    const bool last = l == DEPTH - 1;
    float* const xdst = dry ? p.bufB : p.xcur; float* const odst = dry ? p.bufB : p.out; bf16_t* const hdst = dry ? (bf16_t*)(p.bufB + (size_t)NT * D_MODEL) : p.h;
    for (int t = gw; t < ntok; t += ngw) {
        const int idx0 = p.pidx[(size_t)t * NPAIR + lane], idx1 = p.pidx[(size_t)t * NPAIR + 64 + lane];
        const float g0 = p.pg[(size_t)t * NPAIR + lane], g1 = p.pg[(size_t)t * NPAIR + 64 + lane];
        const float su0 = su[idx0], su1 = su[idx1], sv0 = svs[idx0], sv1 = svs[idx1];
        f32x2 hv[4][2];
#pragma unroll
        for (int i = 0; i < 4; ++i) { const uint2 w = *(const uint2*)(p.h + (size_t)t * D_MODEL + 256 * i + 4 * lane);
            hv[i][0] = (f32x2){__uint_as_float(w.x << 16), __uint_as_float(w.x & 0xffff0000u)}; hv[i][1] = (f32x2){__uint_as_float(w.y << 16), __uint_as_float(w.y & 0xffff0000u)}; }
        float dots[8];
        u32x4 buf[PG_B];
#pragma unroll 1
        for (int bt = 0; bt < 8; ++bt) {
            const int iv = bt < 4 ? idx0 : idx1;
#pragma unroll
            for (int r = 0; r < PG_B; ++r) { const int e = __builtin_amdgcn_readlane(iv, ((bt & 3) * PG_B + r)); buf[r] = *(const u32x4*)(U + (size_t)e * D_MODEL); }
            float part[PG_B];
#pragma unroll
            for (int r = 0; r < PG_B; ++r) { f32x2 a = (f32x2){0.f, 0.f}, b2 = (f32x2){0.f, 0.f};
#pragma unroll
                for (int i = 0; i < 4; ++i) { const f32x2 c0 = __builtin_amdgcn_cvt_pk_f32_fp8((int)buf[r][i], false), c1 = __builtin_amdgcn_cvt_pk_f32_fp8((int)buf[r][i], true);
                    a = c0 * hv[i][0] + a; b2 = c1 * hv[i][1] + b2; }
                part[r] = (a[0] + a[1]) + (b2[0] + b2[1]); }
            float r8[8], r4[4], r2[2], r1;
            const bool b5 = lane & 32, b4 = lane & 16, b3 = lane & 8, b2_ = lane & 4;
#pragma unroll
            for (int j = 0; j < 8; ++j) { const float keep = b5 ? part[j + 8] : part[j], send = b5 ? part[j] : part[j + 8]; r8[j] = keep + __shfl_xor(send, 32); }
#pragma unroll
            for (int j = 0; j < 4; ++j) { const float keep = b4 ? r8[j + 4] : r8[j], send = b4 ? r8[j] : r8[j + 4]; r4[j] = keep + __shfl_xor(send, 16); }
#pragma unroll
            for (int j = 0; j < 2; ++j) { const float keep = b3 ? r4[j + 2] : r4[j], send = b3 ? r4[j] : r4[j + 2]; r2[j] = keep + __shfl_xor(send, 8); }
            { const float keep = b2_ ? r2[1] : r2[0], send = b2_ ? r2[0] : r2[1]; r1 = keep + __shfl_xor(send, 4); }
            r1 += __shfl_xor(r1, 2); r1 += __shfl_xor(r1, 1);
#pragma unroll
            for (int q = 0; q < 8; ++q) if (q == bt) dots[q] = r1;
        }
        float d0, d1;
        { const int src = 4 * (lane & 15), sel = lane >> 4;
          const float t0 = __shfl(dots[0], src), t1 = __shfl(dots[1], src), t2 = __shfl(dots[2], src), t3 = __shfl(dots[3], src);
          d0 = sel == 0 ? t0 : sel == 1 ? t1 : sel == 2 ? t2 : t3;
          const float t4 = __shfl(dots[4], src), t5 = __shfl(dots[5], src), t6 = __shfl(dots[6], src), t7 = __shfl(dots[7], src);
          d1 = sel == 0 ? t4 : sel == 1 ? t5 : sel == 2 ? t6 : t7; }
        const float w0 = g0 * gelu_dev(d0 * su0) * sv0, w1 = g1 * gelu_dev(d1 * su1) * sv1;
        f32x2 acc[4][2];
#pragma unroll
        for (int i = 0; i < 4; ++i) { acc[i][0] = (f32x2){0.f, 0.f}; acc[i][1] = (f32x2){0.f, 0.f}; }
#pragma unroll 1
        for (int bt = 0; bt < 8; ++bt) {
            const int iv = bt < 4 ? idx0 : idx1; const float wv = bt < 4 ? w0 : w1;
#pragma unroll
            for (int r = 0; r < PG_B; ++r) { const int e = __builtin_amdgcn_readlane(iv, ((bt & 3) * PG_B + r)); buf[r] = *(const u32x4*)(V + (size_t)e * D_MODEL); }
#pragma unroll
            for (int r = 0; r < PG_B; ++r) { const float w = __uint_as_float(__builtin_amdgcn_readlane(__float_as_uint(wv), ((bt & 3) * PG_B + r))); const f32x2 w2 = (f32x2){w, w};
#pragma unroll
                for (int i = 0; i < 4; ++i) { const f32x2 c0 = __builtin_amdgcn_cvt_pk_f32_fp8((int)buf[r][i], false), c1 = __builtin_amdgcn_cvt_pk_f32_fp8((int)buf[r][i], true);
                    acc[i][0] = c0 * w2 + acc[i][0]; acc[i][1] = c1 * w2 + acc[i][1]; } }
        }
        const float* gate = ada_ptr(p, l, t, 5);
        f32x4 xn[4]; float ss = 0.f;
#pragma unroll
        for (int i = 0; i < 4; ++i) { const int d = 256 * i + 4 * lane; const f32x4 gt = *(const f32x4*)(gate + d); const f32x4 xo = *(const f32x4*)(p.xcur + (size_t)t * D_MODEL + d);
            xn[i] = xo + gt * (f32x4){acc[i][0][0], acc[i][0][1], acc[i][1][0], acc[i][1][1]};
            ss += (xn[i][0] * xn[i][0] + xn[i][1] * xn[i][1]) + (xn[i][2] * xn[i][2] + xn[i][3] * xn[i][3]); }
        if (last) {
#pragma unroll
            for (int i = 0; i < 4; ++i) *(f32x4*)(odst + (size_t)t * D_MODEL + 256 * i + 4 * lane) = xn[i];
        } else {
            const float rs = 1.0f / sqrtf(wave_sum(ss) * (1.0f / D_MODEL) + EPS);
            const float* sh = ada_ptr(p, l + 1, t, 0); const float* sc = ada_ptr(p, l + 1, t, 1); const float* ng = p.norm1_g + (size_t)(l + 1) * D_MODEL;
#pragma unroll
            for (int i = 0; i < 4; ++i) { const int d = 256 * i + 4 * lane; *(f32x4*)(xdst + (size_t)t * D_MODEL + d) = xn[i];
                const f32x4 g4 = *(const f32x4*)(ng + d), s4 = *(const f32x4*)(sh + d), c4 = *(const f32x4*)(sc + d);
                const f32x4 hh = xn[i] * rs * g4 * (c4 + 1.0f) + s4;
                uint2 o; o.x = pk_bf16(hh[0], hh[1]); o.y = pk_bf16(hh[2], hh[3]); *(uint2*)(hdst + (size_t)t * D_MODEL + d) = o; }
        }
    }
}


typedef float f32x16 __attribute__((ext_vector_type(16)));
__device__ __forceinline__ int mono_i(float x) { const int i = __float_as_int(x); return i ^ ((i >> 31) & 0x7fffffff); }
__device__ __forceinline__ float mono_f(int m) { return __int_as_float(m ^ ((m >> 31) & 0x7fffffff)); }
#define CE_DESC(a, b) do { const int _mx = (a) > (b) ? (a) : (b), _mn = (a) > (b) ? (b) : (a); (a) = _mx; (b) = _mn; } while (0)
__device__ __forceinline__ void sort16_desc(int (&v)[16]) {
    CE_DESC(v[0], v[13]); CE_DESC(v[1], v[12]); CE_DESC(v[2], v[15]); CE_DESC(v[3], v[14]); CE_DESC(v[4], v[8]); CE_DESC(v[5], v[6]); CE_DESC(v[7], v[11]); CE_DESC(v[9], v[10]);
    CE_DESC(v[0], v[5]); CE_DESC(v[1], v[7]); CE_DESC(v[2], v[9]); CE_DESC(v[3], v[4]); CE_DESC(v[6], v[13]); CE_DESC(v[8], v[14]); CE_DESC(v[10], v[15]); CE_DESC(v[11], v[12]);
    CE_DESC(v[0], v[1]); CE_DESC(v[2], v[3]); CE_DESC(v[4], v[5]); CE_DESC(v[6], v[8]); CE_DESC(v[7], v[9]); CE_DESC(v[10], v[11]); CE_DESC(v[12], v[13]); CE_DESC(v[14], v[15]);
    CE_DESC(v[0], v[2]); CE_DESC(v[1], v[3]); CE_DESC(v[4], v[10]); CE_DESC(v[5], v[11]); CE_DESC(v[6], v[7]); CE_DESC(v[8], v[9]); CE_DESC(v[12], v[14]); CE_DESC(v[13], v[15]);
    CE_DESC(v[1], v[2]); CE_DESC(v[3], v[12]); CE_DESC(v[4], v[6]); CE_DESC(v[5], v[7]); CE_DESC(v[8], v[10]); CE_DESC(v[9], v[11]); CE_DESC(v[13], v[14]);
    CE_DESC(v[1], v[4]); CE_DESC(v[2], v[6]); CE_DESC(v[5], v[8]); CE_DESC(v[7], v[10]); CE_DESC(v[9], v[13]); CE_DESC(v[11], v[14]);
    CE_DESC(v[2], v[4]); CE_DESC(v[3], v[6]); CE_DESC(v[9], v[12]); CE_DESC(v[11], v[13]);
    CE_DESC(v[3], v[5]); CE_DESC(v[6], v[8]); CE_DESC(v[7], v[9]); CE_DESC(v[10], v[12]);
    CE_DESC(v[3], v[4]); CE_DESC(v[5], v[6]); CE_DESC(v[7], v[8]); CE_DESC(v[9], v[10]); CE_DESC(v[11], v[12]);
    CE_DESC(v[6], v[7]); CE_DESC(v[8], v[9]);
}
template <int LOGN> __device__ __forceinline__ void bitonic_sort_desc(int (&v)[1 << LOGN]) {
#pragma unroll
    for (int lk = 1; lk <= LOGN; ++lk)
#pragma unroll
        for (int lj = lk - 1; lj >= 0; --lj)
#pragma unroll
            for (int i = 0; i < (1 << LOGN); ++i) { const int k = 1 << lk, j = 1 << lj, l = i ^ j; if (l > i) { if ((i & k) == 0) CE_DESC(v[i], v[l]); else CE_DESC(v[l], v[i]); } }
}
__device__ __forceinline__ void merge_top16(int (&a)[16], const int (&b)[16]) {
#pragma unroll
    for (int i = 0; i < 16; ++i) a[i] = a[i] > b[15 - i] ? a[i] : b[15 - i];
#pragma unroll
    for (int lj = 3; lj >= 0; --lj)
#pragma unroll
        for (int i = 0; i < 16; ++i) { const int j = 1 << lj, l = i ^ j; if (l > i) CE_DESC(a[i], a[l]); }
}
__device__ __forceinline__ void topk_half(LAS unsigned char* lds, int ph, int r31, int hi, bf16x8 (&bq)[8], const bf16_t* next_qrow, int (&L)[16]) {
    f32x16 acc[4];
#pragma unroll
    for (int mb = 0; mb < 4; ++mb)
#pragma unroll
        for (int r = 0; r < 16; ++r) acc[mb][r] = 0.f;
    bf16x8 akA[4], akB[4];
#pragma unroll
    for (int mb = 0; mb < 4; ++mb) { const int key = 32 * mb + r31; akA[mb] = *(const LAS bf16x8*)(lds + ph * 32768 + key * 256 + (((0 + hi) ^ (key & 15)) << 4)); }
#pragma unroll
    for (int s2 = 0; s2 < 4; ++s2) {
#pragma unroll
        for (int mb = 0; mb < 4; ++mb) { const int key = 32 * mb + r31; akB[mb] = *(const LAS bf16x8*)(lds + ph * 32768 + key * 256 + (((2 * (2 * s2 + 1) + hi) ^ (key & 15)) << 4)); }
        __builtin_amdgcn_sched_barrier(0);
#pragma unroll
        for (int mb = 0; mb < 4; ++mb) acc[mb] = __builtin_amdgcn_mfma_f32_32x32x16_bf16(akA[mb], bq[2 * s2], acc[mb], 0, 0, 0);
        __builtin_amdgcn_sched_barrier(0);
        if (s2 < 3) {
#pragma unroll
            for (int mb = 0; mb < 4; ++mb) { const int key = 32 * mb + r31; akA[mb] = *(const LAS bf16x8*)(lds + ph * 32768 + key * 256 + (((2 * (2 * s2 + 2) + hi) ^ (key & 15)) << 4)); } }
        __builtin_amdgcn_sched_barrier(0);
#pragma unroll
        for (int mb = 0; mb < 4; ++mb) acc[mb] = __builtin_amdgcn_mfma_f32_32x32x16_bf16(akB[mb], bq[2 * s2 + 1], acc[mb], 0, 0, 0);
        __builtin_amdgcn_sched_barrier(0);
    }
#pragma unroll
    for (int s = 0; s < 8; ++s) bq[s] = *(const bf16x8*)(next_qrow + 16 * s);
    __builtin_amdgcn_sched_barrier(0);
#pragma unroll
    for (int mb = 0; mb < 4; ++mb) { int g[16];
#pragma unroll
        for (int r = 0; r < 16; ++r) { const int key = 32 * mb + 8 * (r >> 2) + 4 * hi + (r & 3); g[r] = (mono_i(acc[mb][r]) & ~127) | key; }
        sort16_desc(g);
        if (mb == 0) {
#pragma unroll
            for (int r = 0; r < 16; ++r) L[r] = g[r];
        } else merge_top16(L, g);
        __builtin_amdgcn_sched_barrier(0); }
    int Pn[16];
#pragma unroll
    for (int r = 0; r < 16; ++r) { auto sw = __builtin_amdgcn_permlane32_swap((unsigned)L[r], (unsigned)L[r], false, false); Pn[r] = (int)(hi ? sw[0] : sw[1]); }
    merge_top16(L, Pn);
}
#define TK_LDS0 1024
__device__ __forceinline__ void phase_peer_topk(const P& p, LAS unsigned char* lds0, int l, int ntok) {
    LAS unsigned char* lds = lds0 + TK_LDS0;
    const int tid = tid_opaque(), lane = tid & 63, wave = tid >> 6, hh = blockIdx.x % PEER_HEADS, jb = blockIdx.x / PEER_HEADS, nj = gridDim.x / PEER_HEADS;
    const float* sk = p.peer_subkeys + ((size_t)l * PEER_HEADS + hh) * 2 * PEER_KEYS * (PEER_QDIM / 2);
    for (int c = tid; c < 2 * PEER_KEYS * 16; c += NTHREADS) {
        const int ch = c & 15, key = (c >> 4) & 127, ph = c >> 11;
        const f32x4 a = *(const f32x4*)(sk + (size_t)c * 8), b2 = *(const f32x4*)(sk + (size_t)c * 8 + 4);
        u32x4 o; o.x = pk_bf16(a[0], a[1]); o.y = pk_bf16(a[2], a[3]); o.z = pk_bf16(b2[0], b2[1]); o.w = pk_bf16(b2[2], b2[3]);
        *(LAS u32x4*)(lds + ph * 32768 + key * 256 + ((ch ^ (key & 15)) << 4)) = o;
    }
    __syncthreads();
    const int r31 = lane & 31, hi = lane >> 5;
    const int ntiles = ntok / 32;
    bf16x8 bq[8];
    { const int ti0 = jb * (NTHREADS / 64) + wave < ntiles ? jb * (NTHREADS / 64) + wave : 0; const bf16_t* q0 = p.bufA + (size_t)(ti0 * 32 + r31) * PQW + hh * PEER_QDIM + 8 * hi;
#pragma unroll
      for (int s = 0; s < 8; ++s) bq[s] = *(const bf16x8*)(q0 + 16 * s); }
    for (int ti = jb * (NTHREADS / 64) + wave; ti < ntiles; ti += nj * (NTHREADS / 64)) {
        const int tok = ti * 32 + r31;
        int La[16], Lb[16];
        const bf16_t* q1 = p.bufA + (size_t)tok * PQW + hh * PEER_QDIM + (PEER_QDIM / 2) + 8 * hi;
        const int tin = ti + nj * (NTHREADS / 64) < ntiles ? ti + nj * (NTHREADS / 64) : ti;
        const bf16_t* q2 = p.bufA + (size_t)(tin * 32 + r31) * PQW + hh * PEER_QDIM + 8 * hi;
        topk_half(lds, 0, r31, hi, bq, q1, La);
        __builtin_amdgcn_sched_barrier(0);
        topk_half(lds, 1, r31, hi, bq, q2, Lb);
        __builtin_amdgcn_sched_barrier(0);
#define TK_CAND(i, j) ((mono_i(mono_f(La[i] & ~127) + mono_f(Lb[j] & ~127)) & ~0x3fff) | ((La[i] & 127) << 7) | (Lb[j] & 127))
        int T[16];
        { int g[16];
          g[0] = TK_CAND(0, 0);
          g[1] = TK_CAND(0, 1);
          g[2] = TK_CAND(0, 2);
          g[3] = TK_CAND(0, 3);
          g[4] = TK_CAND(0, 4);
          g[5] = TK_CAND(0, 5);
          g[6] = TK_CAND(0, 6);
          g[7] = TK_CAND(0, 7);
          g[8] = TK_CAND(0, 8);
          g[9] = TK_CAND(0, 9);
          g[10] = TK_CAND(0, 10);
          g[11] = TK_CAND(0, 11);
          g[12] = TK_CAND(0, 12);
          g[13] = TK_CAND(0, 13);
          g[14] = TK_CAND(0, 14);
          g[15] = TK_CAND(0, 15);
          sort16_desc(g);
          _Pragma("unroll") for (int r = 0; r < 16; ++r) T[r] = g[r]; }
        { int g[16];
          g[0] = TK_CAND(1, 0);
          g[1] = TK_CAND(1, 1);
          g[2] = TK_CAND(1, 2);
          g[3] = TK_CAND(1, 3);
          g[4] = TK_CAND(1, 4);
          g[5] = TK_CAND(1, 5);
          g[6] = TK_CAND(1, 6);
          g[7] = TK_CAND(1, 7);
          g[8] = TK_CAND(2, 0);
          g[9] = TK_CAND(2, 1);
          g[10] = TK_CAND(2, 2);
          g[11] = TK_CAND(2, 3);
          g[12] = TK_CAND(2, 4);
          g[13] = TK_CAND(3, 0);
          g[14] = TK_CAND(3, 1);
          g[15] = TK_CAND(3, 2);
          sort16_desc(g);
          merge_top16(T, g); }
        { int g[16];
          g[0] = TK_CAND(3, 3);
          g[1] = TK_CAND(4, 0);
          g[2] = TK_CAND(4, 1);
          g[3] = TK_CAND(4, 2);
          g[4] = TK_CAND(5, 0);
          g[5] = TK_CAND(5, 1);
          g[6] = TK_CAND(6, 0);
          g[7] = TK_CAND(6, 1);
          g[8] = TK_CAND(7, 0);
          g[9] = TK_CAND(7, 1);
          g[10] = TK_CAND(8, 0);
          g[11] = TK_CAND(9, 0);
          g[12] = TK_CAND(10, 0);
          g[13] = TK_CAND(11, 0);
          g[14] = TK_CAND(12, 0);
          g[15] = TK_CAND(13, 0);
          sort16_desc(g);
          merge_top16(T, g); }
        { int g[16];
          g[0] = TK_CAND(14, 0);
          g[1] = TK_CAND(15, 0);
          g[2] = (int)0x80000000;
          g[3] = (int)0x80000000;
          g[4] = (int)0x80000000;
          g[5] = (int)0x80000000;
          g[6] = (int)0x80000000;
          g[7] = (int)0x80000000;
          g[8] = (int)0x80000000;
          g[9] = (int)0x80000000;
          g[10] = (int)0x80000000;
          g[11] = (int)0x80000000;
          g[12] = (int)0x80000000;
          g[13] = (int)0x80000000;
          g[14] = (int)0x80000000;
          g[15] = (int)0x80000000;
          sort16_desc(g);
          merge_top16(T, g); }
        float e[16]; float sum = 0.f; const float c0 = mono_f(T[0] & ~0x3fff);
#pragma unroll
        for (int r = 0; r < 16; ++r) { e[r] = __expf(mono_f(T[r] & ~0x3fff) - c0); sum += e[r]; }
        const float inv = 1.0f / sum;
        if (hi == 0) {
            unsigned short* oi = p.pidx16 + (size_t)tok * NPAIR + hh * PEER_TOPK; float* og = p.pg + (size_t)tok * NPAIR + hh * PEER_TOPK;
#pragma unroll
            for (int r4 = 0; r4 < 4; ++r4) {
                *(uint2*)(oi + 4 * r4) = make_uint2((unsigned)(T[4 * r4] & 0x3fff) | ((unsigned)(T[4 * r4 + 1] & 0x3fff) << 16), (unsigned)(T[4 * r4 + 2] & 0x3fff) | ((unsigned)(T[4 * r4 + 3] & 0x3fff) << 16));
                *(f32x4*)(og + 4 * r4) = (f32x4){e[4 * r4] * inv, e[4 * r4 + 1] * inv, e[4 * r4 + 2] * inv, e[4 * r4 + 3] * inv}; }
        }
    }
}


__device__ __forceinline__ void phase_rope_table(const P& p) {
    const int nf = D_HEAD_DIM / 4;
    for (int i = blockIdx.x * NTHREADS + tid_opaque(); i < SEQ * (D_HEAD_DIM / 2); i += gridDim.x * NTHREADS) {
        const int pos = i / (D_HEAD_DIM / 2), a = i % (D_HEAD_DIM / 2), fi = a % nf;
        const float inv = exp2f(-(float)fi * (13.287712379549449f / (float)nf)); const float ang = (float)(a < nf ? pos / GRID_W : pos % GRID_W) * inv;
        float sn, cs; sincosf(ang, &sn, &cs); p.rope[2 * i] = cs; p.rope[2 * i + 1] = sn; }
}
__device__ __forceinline__ void phase_attn_prep(const P& p, int l) {
    const int tid = tid_opaque(); const int lane = tid & 63, gw = blockIdx.x * (NTHREADS / 64) + (tid >> 6), ngw = gridDim.x * (NTHREADS / 64);
    {
        const float qscale = 1.4426950408889634f / sqrtf((float)D_HEAD_DIM);
        const int vsel = lane >> 2, sub = lane & 3, hh = vsel >> 2, which = (vsel >> 1) & 1, m = vsel & 1;
        const float* gq = p.d_qk_norm_g + ((size_t)(l / 2) * 2 + which) * D_HEAD_DIM + 16 * sub;
        f32x4 gqv[4];
#pragma unroll
        for (int i = 0; i < 4; ++i) gqv[i] = *(const f32x4*)(gq + 4 * i);
        const int coff = (2 + which) * MIX_W + hh * 2 * D_HEAD_DIM + m * D_HEAD_DIM + 16 * sub;
#define AP_LOAD(RAW, RP, T) { const int tt = (T) < NT ? (T) : gw; const bf16_t* s = p.bufA + (size_t)tt * IN_W + coff; RAW[0] = *(const u32x4*)s; RAW[1] = *(const u32x4*)(s + 8); \
            const int pz = tt < NLAT ? tt % SEQ : 0; const float* rr = p.rope + ((size_t)pz * (D_HEAD_DIM / 2) + 8 * sub) * 2; _Pragma("unroll") for (int i = 0; i < 4; ++i) RP[i] = *(const f32x4*)(rr + 4 * i); }
        u32x4 rawn[2]; f32x4 rpn[4];
        if (gw < NT) AP_LOAD(rawn, rpn, gw);
        for (int t = gw; t < NT; t += ngw) {
            u32x4 raw[2]; f32x4 rp[4];
#pragma unroll
            for (int i = 0; i < 2; ++i) raw[i] = rawn[i];
#pragma unroll
            for (int i = 0; i < 4; ++i) rp[i] = rpn[i];
            AP_LOAD(rawn, rpn, t + ngw);
            float ss = 0.f;
#pragma unroll
            for (int c = 0; c < 2; ++c)
#pragma unroll
                for (int k = 0; k < 4; ++k) { const float a0 = __uint_as_float(raw[c][k] << 16), b0 = __uint_as_float(raw[c][k] & 0xffff0000u); ss += a0 * a0 + b0 * b0; }
            ss += WRED_DPP(ss, 0xB1); ss += WRED_DPP(ss, 0x4E);
            const float rs = (1.0f / sqrtf(ss * (1.0f / D_HEAD_DIM) + EPS)) * (which == 0 ? qscale : 1.0f);
            const bool lat = t < NLAT; const int pos = lat ? t % SEQ : (t - NLAT) % CTX_LEN, bb = lat ? t / SEQ : (t - NLAT) / CTX_LEN;
            u32x4 o[2];
#pragma unroll
            for (int c = 0; c < 2; ++c)
#pragma unroll
                for (int k = 0; k < 4; ++k) { const int ip = 4 * c + k;
                    const float t1 = __uint_as_float(raw[c][k] << 16) * rs * gqv[ip >> 1][2 * (ip & 1)], t2 = __uint_as_float(raw[c][k] & 0xffff0000u) * rs * gqv[ip >> 1][2 * (ip & 1) + 1];
                    const float cs = lat ? rp[ip >> 1][2 * (ip & 1)] : 1.0f, sn = lat ? rp[ip >> 1][2 * (ip & 1) + 1] : 0.0f;
                    o[c][k] = pk_bf16(t1 * cs - t2 * sn, t1 * sn + t2 * cs); }
            bf16_t* dst = which == 0 ? p.qp + ((((size_t)bb * D_HEADS + hh) * 2 + m) * SEQ + pos) * D_HEAD_DIM + 16 * sub
                                     : p.kp + ((((size_t)bb * D_HEADS + hh) * 2 + m) * LKV + (lat ? CTX_LEN + pos : pos)) * D_HEAD_DIM + 16 * sub;
            if (lat || which == 1) { *(u32x4*)dst = o[0]; *(u32x4*)(dst + 8) = o[1]; }
        }
#undef AP_LOAD
    }
    const int ntile = LKV / 64;
    for (int it = gw; it < BATCH * D_HEADS * ntile; it += ngw) {
        const int kt = it % ntile, hh = (it / ntile) % D_HEADS, bb = it / (ntile * D_HEADS);
        const int row0 = kt < CTX_LEN / 64 ? NLAT + bb * CTX_LEN + kt * 64 : bb * SEQ + (kt - CTX_LEN / 64) * 64;
        const bf16_t* vbase = p.bufA + (size_t)row0 * IN_W + 4 * MIX_W + hh * 2 * D_HEAD_DIM + 2 * lane;
        unsigned w0[32], w1[32];
#pragma unroll
        for (int k2 = 0; k2 < 32; ++k2) {
            const int pp = 2 * k2, ko = (pp & 32) + 16 * ((pp >> 2) & 1) + 4 * ((pp >> 3) & 3) + (pp & 3);
            w0[k2] = *(const unsigned*)(vbase + (size_t)ko * IN_W); w1[k2] = *(const unsigned*)(vbase + (size_t)(ko + 1) * IN_W); }
        __builtin_amdgcn_sched_barrier(0);
#pragma unroll
        for (int k2 = 0; k2 < 32; ++k2) { const unsigned a = w0[k2], c = w1[k2]; w0[k2] = (a & 0xffffu) | (c << 16); w1[k2] = (a >> 16) | (c & 0xffff0000u); }
        bf16_t* dst = p.vt + (((size_t)bb * D_HEADS + hh) * 2 * D_HEAD_DIM + 2 * lane) * LKV + kt * 64;
#pragma unroll
        for (int c = 0; c < 8; ++c) { *(u32x4*)(dst + 8 * c) = (u32x4){w0[4 * c], w0[4 * c + 1], w0[4 * c + 2], w0[4 * c + 3]}; *(u32x4*)(dst + LKV + 8 * c) = (u32x4){w1[4 * c], w1[4 * c + 1], w1[4 * c + 2], w1[4 * c + 3]}; }
    }
}
__device__ __forceinline__ float quad4_max(float v) {
    auto a = __builtin_amdgcn_permlane32_swap(__float_as_uint(v), __float_as_uint(v), false, false); v = fmaxf(__uint_as_float(a[0]), __uint_as_float(a[1]));
    auto c = __builtin_amdgcn_permlane16_swap(__float_as_uint(v), __float_as_uint(v), false, false); return fmaxf(__uint_as_float(c[0]), __uint_as_float(c[1])); }
__device__ __forceinline__ float quad4_sum(float v) {
    auto a = __builtin_amdgcn_permlane32_swap(__float_as_uint(v), __float_as_uint(v), false, false); v = __uint_as_float(a[0]) + __uint_as_float(a[1]);
    auto c = __builtin_amdgcn_permlane16_swap(__float_as_uint(v), __float_as_uint(v), false, false); return __uint_as_float(c[0]) + __uint_as_float(c[1]); }
#define AT_LDS0 1024
#define AT_THR 11.5f
#define AT_KBYTES (2 * 64 * 128)
#define AT_VROW 128
#define AT_VBYTES (128 * AT_VROW)
#define AT_STAGE (AT_KBYTES + AT_VBYTES)
__device__ __forceinline__ void phase_attention(const P& p, LAS unsigned char* lds0, int l) {
    LAS unsigned char* lds = lds0 + AT_LDS0;
    const int tid = tid_opaque(), lane = tid & 63, wave = tid >> 6, fr = lane & 15, g = lane >> 4;
    const int mw = wave >> 2, wq = wave & 3;
    const float lam = lam_val(p, l), li = lam_init_f(l);
    float gqm = 0.f, gkm = 0.f;
    { const float* gq = p.d_qk_norm_g + (size_t)(l / 2) * 2 * D_HEAD_DIM;
      for (int i = 0; i < D_HEAD_DIM; ++i) { gqm = fmaxf(gqm, fabsf(gq[i])); gkm = fmaxf(gkm, fabsf(gq[D_HEAD_DIM + i])); } }
    const float SM = sqrtf((float)D_HEAD_DIM) * gqm * gkm * 1.4426950408889634f;
    const int nxg = (gridDim.x % 8 == 0) ? 8 : 1, xg = blockIdx.x % nxg, jb = blockIdx.x / nxg, nj = gridDim.x / nxg;
    const int QB = SEQ / 128, npair = BATCH * D_HEADS, nunit = npair * QB;
    const int nloc = ((npair - xg + nxg - 1) / nxg) * QB;
    const int ntile = LKV / 64;
    for (int u = jb; u < nloc; u += nj) {
        const int pair = (u / QB) * nxg + xg, qb = u % QB, bb = pair / D_HEADS, hh = pair % D_HEADS;
        const int q0 = qb * 128 + wq * 32;
        bf16x8 bq[2][2];
#pragma unroll
        for (int m = 0; m < 2; ++m)
#pragma unroll
            for (int s = 0; s < 2; ++s) bq[m][s] = *(const bf16x8*)(p.qp + ((((size_t)bb * D_HEADS + hh) * 2 + mw) * SEQ + q0 + 16 * m + fr) * D_HEAD_DIM + 32 * s + 8 * g);
        f32x4 O[2][8]; float lrun[2] = {0.f, 0.f};
#pragma unroll
        for (int m = 0; m < 2; ++m)
#pragma unroll
            for (int eb = 0; eb < 8; ++eb) O[m][eb] = (f32x4){0.f, 0.f, 0.f, 0.f};
        const int krow = (tid >> 3) & 63, kch = tid & 7;
        const __amdgpu_buffer_rsrc_t krs = __builtin_amdgcn_make_buffer_rsrc((void*)p.kp, 0, (int)((size_t)BATCH * D_HEADS * 2 * LKV * D_HEAD_DIM * 2), 0x00020000);
        const __amdgpu_buffer_rsrc_t vrs = __builtin_amdgcn_make_buffer_rsrc((void*)p.vt, 0, (int)((size_t)BATCH * D_HEADS * 2 * D_HEAD_DIM * LKV * 2), 0x00020000);
        const int kvo = krow * 128 + kch * 16, vvo = (tid >> 3) * (LKV * 2) + kch * 16;
        const int ks0 = (int)((((size_t)bb * D_HEADS + hh) * 2) * LKV * D_HEAD_DIM * 2), ks1 = ks0 + LKV * D_HEAD_DIM * 2;
        const int vs0 = (int)(((size_t)bb * D_HEADS + hh) * 2 * D_HEAD_DIM * LKV * 2), vs1 = vs0 + 64 * LKV * 2;
#define AT_LOADT(KT, K0, K1, V0, V1) { const int kto = (KT) * 64 * D_HEAD_DIM * 2, vto = (KT) * 64 * 2; \
            K0 = __builtin_amdgcn_raw_buffer_load_b128(krs, kvo, ks0 + kto, 0); K1 = __builtin_amdgcn_raw_buffer_load_b128(krs, kvo, ks1 + kto, 0); \
            V0 = __builtin_amdgcn_raw_buffer_load_b128(vrs, vvo, vs0 + vto, 0); V1 = __builtin_amdgcn_raw_buffer_load_b128(vrs, vvo, vs1 + vto, 0); }
        const int klds = krow * 128 + ((kch ^ ((krow >> 1) & 7)) << 4);
        const int vlds = AT_KBYTES + (tid >> 3) * AT_VROW + ((kch ^ (((tid >> 3) >> 1) & 7)) << 4);
        u32x4 rak0, rak1, rav0, rav1;
        AT_LOADT(0, rak0, rak1, rav0, rav1);
        *(LAS u32x4*)(lds + klds) = rak0; *(LAS u32x4*)(lds + 8192 + klds) = rak1; *(LAS u32x4*)(lds + vlds) = rav0; *(LAS u32x4*)(lds + vlds + 64 * AT_VROW) = rav1;
        __syncthreads();
        const unsigned koff0 = fr * 128 + ((g ^ ((fr >> 1) & 7)) << 4), koff1 = fr * 128 + (((g ^ ((fr >> 1) & 7)) ^ 4) << 4), voff0 = AT_KBYTES + fr * AT_VROW + ((g ^ ((fr >> 1) & 7)) << 4), voff1 = AT_KBYTES + fr * AT_VROW + (((g ^ ((fr >> 1) & 7)) ^ 4) << 4);
        auto tile = [&](LAS unsigned char* cur_) {
            unsigned cb = (unsigned)(size_t)cur_; asm volatile("" : "+v"(cb));
            LAS unsigned char* const ck0 = (LAS unsigned char*)(size_t)(cb + koff0 + mw * 8192); LAS unsigned char* const ck1 = (LAS unsigned char*)(size_t)(cb + koff1 + mw * 8192); LAS unsigned char* const cv0 = (LAS unsigned char*)(size_t)(cb + voff0); LAS unsigned char* const cv1 = (LAS unsigned char*)(size_t)(cb + voff1);
            bf16x8 pf[2][2]; bf16x8 kA[2][2], kB[2][2], vA[2][2], vB[2][2]; f32x4 S[4];
#define AT_LDK(dst, k2) { _Pragma("unroll") for (int kq = 0; kq < 2; ++kq) _Pragma("unroll") for (int s = 0; s < 2; ++s) dst[kq][s] = *(const LAS bf16x8*)((s ? ck1 : ck0) + (2 * (k2) + kq) * 2048); }
#define AT_MMK(src, m, k2) { _Pragma("unroll") for (int kq = 0; kq < 2; ++kq) { S[2 * (k2) + kq] = (f32x4){-SM, -SM, -SM, -SM}; _Pragma("unroll") for (int s = 0; s < 2; ++s) S[2 * (k2) + kq] = __builtin_amdgcn_mfma_f32_16x16x32_bf16(src[kq][s], bq[m][s], S[2 * (k2) + kq], 0, 0, 0); } }
#define AT_LDV(dv, hf) { _Pragma("unroll") for (int e4 = 0; e4 < 2; ++e4) _Pragma("unroll") for (int ks = 0; ks < 2; ++ks) dv[e4][ks] = *(const LAS bf16x8*)((ks ? cv1 : cv0) + (16 * (2 * (hf) + e4)) * AT_VROW); }
#define AT_MMV(dv, hf) { _Pragma("unroll") for (int e4 = 0; e4 < 2; ++e4) _Pragma("unroll") for (int ks = 0; ks < 2; ++ks) { const int eb = 2 * (hf) + e4; \
                O[0][eb] = __builtin_amdgcn_mfma_f32_16x16x32_bf16(dv[e4][ks], pf[0][ks], O[0][eb], 0, 0, 0); O[1][eb] = __builtin_amdgcn_mfma_f32_16x16x32_bf16(dv[e4][ks], pf[1][ks], O[1][eb], 0, 0, 0); } }
#define AT_SOFTMAX(m) { float ls = 0.f; \
                _Pragma("unroll") for (int kb = 0; kb < 4; ++kb) _Pragma("unroll") for (int r = 0; r < 4; ++r) { const float e = __builtin_amdgcn_exp2f(S[kb][r]); S[kb][r] = e; ls += e; } \
                lrun[m] += ls; \
                _Pragma("unroll") for (int ks = 0; ks < 2; ++ks) { u32x4 w; w.x = pk_bf16(S[2 * ks][0], S[2 * ks][1]); w.y = pk_bf16(S[2 * ks][2], S[2 * ks][3]); w.z = pk_bf16(S[2 * ks + 1][0], S[2 * ks + 1][1]); w.w = pk_bf16(S[2 * ks + 1][2], S[2 * ks + 1][3]); \
                    pf[m][ks] = __builtin_bit_cast(bf16x8, w); } }
#define AT_PIN __builtin_amdgcn_sched_barrier(0)
            AT_LDK(kA, 0); AT_LDK(kB, 1); AT_PIN;
            AT_MMK(kA, 0, 0); AT_PIN; AT_LDV(vA, 0); AT_PIN;
            AT_MMK(kB, 0, 1); AT_PIN; AT_LDV(vB, 1); AT_PIN;
            { f32x4 T[4];
#pragma unroll
              for (int i = 0; i < 4; ++i) T[i] = S[i];
              AT_MMK(kA, 1, 0); AT_MMK(kB, 1, 1); AT_PIN;
              { f32x4 U[4];
#pragma unroll
                for (int i = 0; i < 4; ++i) { U[i] = S[i]; S[i] = T[i]; }
                AT_SOFTMAX(0); AT_PIN;
#pragma unroll
                for (int i = 0; i < 4; ++i) S[i] = U[i]; } }
            AT_SOFTMAX(1); AT_PIN;
            AT_MMV(vA, 0); AT_PIN; AT_LDV(vA, 2); AT_PIN;
            AT_MMV(vB, 1); AT_PIN; AT_LDV(vB, 3); AT_PIN;
            AT_MMV(vA, 2); AT_PIN;
            AT_MMV(vB, 3);
#undef AT_LDK
#undef AT_MMK
#undef AT_LDV
#undef AT_MMV
#undef AT_SOFTMAX
#undef AT_PIN
        };
        for (int kt = 0; kt < ntile; ++kt) {
            LAS unsigned char* cur = lds + (kt & 1) * AT_STAGE; LAS unsigned char* nxt = lds + ((kt + 1) & 1) * AT_STAGE;
            { const int k1 = kt + 1 < ntile ? kt + 1 : ntile - 1; AT_LOADT(k1, rak0, rak1, rav0, rav1); }
            tile(cur);
            if (kt + 1 < ntile) { *(LAS u32x4*)(nxt + klds) = rak0; *(LAS u32x4*)(nxt + 8192 + klds) = rak1; *(LAS u32x4*)(nxt + vlds) = rav0; *(LAS u32x4*)(nxt + vlds + 64 * AT_VROW) = rav1; }
            __syncthreads();
        }
#undef AT_LOADT
        const float msc = mw == 0 ? 1.0f : lam;
        const float sc[2] = {msc / quad4_sum(lrun[0]), msc / quad4_sum(lrun[1])};
        LAS f32x4* ex = (LAS f32x4*)lds + (size_t)wq * 2 * 8 * 64 + lane;
        if (mw == 1) {
#pragma unroll
            for (int m = 0; m < 2; ++m)
#pragma unroll
                for (int eb = 0; eb < 8; ++eb) ex[(m * 8 + eb) * 64] = O[m][eb] * sc[m]; }
        __syncthreads();
        if (mw == 0) {
            const float* sg = p.d_subln_g + (size_t)(l / 2) * 2 * D_HEAD_DIM;
#pragma unroll
            for (int m = 0; m < 2; ++m) { float ss = 0.f;
#pragma unroll
                for (int eb = 0; eb < 8; ++eb) { O[m][eb] = O[m][eb] * sc[m] - ex[(m * 8 + eb) * 64]; ss += (O[m][eb][0] * O[m][eb][0] + O[m][eb][1] * O[m][eb][1]) + (O[m][eb][2] * O[m][eb][2] + O[m][eb][3] * O[m][eb][3]); }
                ss = quad4_sum(ss);
                const float rs = (1.0f / sqrtf(ss * (1.0f / (2 * D_HEAD_DIM)) + EPS)) * (1.0f - li);
                bf16_t* orow = p.h + (size_t)(bb * SEQ + q0 + 16 * m + fr) * (2 * MIX_W) + MIX_W + hh * 2 * D_HEAD_DIM;
#pragma unroll
                for (int eb = 0; eb < 8; ++eb) { const int e0 = 16 * eb + 4 * g; const f32x4 gg = *(const f32x4*)(sg + e0); const f32x4 y = O[m][eb] * rs * gg;
                    uint2 o; o.x = pk_bf16(y[0], y[1]); o.y = pk_bf16(y[2], y[3]); *(uint2*)(orow + e0) = o; } } }
        __syncthreads();
    }
}


__device__ __forceinline__ void phase_ada(const P& p, LAS unsigned char* lds0) {
    LAS float* sil = (LAS float*)(lds0 + 1024);
    LAS float* red = sil + (BATCH + 1) * D_MODEL;
    const int tid = tid_opaque(), kq = tid >> 4, cq = tid & 15;
    for (int i = tid; i < (BATCH + 1) * D_MODEL; i += NTHREADS) { const int r = i / D_MODEL, k = i % D_MODEL; const float v = r < BATCH ? p.c[(size_t)r * D_MODEL + k] : p.c_ctx[k]; sil[i] = v * __builtin_amdgcn_rcpf(1.0f + __expf(-v)); }
    __syncthreads();
    const int nslab = N_ADA * D_MODEL / 64;
    for (int it = blockIdx.x; it < DEPTH * nslab; it += gridDim.x) {
        const int l = it / nslab, j0 = (it % nslab) * 64 + 4 * cq;
        const float* w = p.w_ada + (size_t)l * D_MODEL * N_ADA * D_MODEL + j0;
        f32x4 acc[BATCH + 1];
#pragma unroll
        for (int r = 0; r <= BATCH; ++r) acc[r] = (f32x4){0.f, 0.f, 0.f, 0.f};
#pragma unroll
        for (int kh = 0; kh < 2; ++kh) { f32x4 wv[16];
#pragma unroll
            for (int kk = 0; kk < 16; ++kk) wv[kk] = *(const f32x4*)(w + (size_t)(kq * 32 + kh * 16 + kk) * N_ADA * D_MODEL);
#pragma unroll
            for (int kk = 0; kk < 16; ++kk) { const int k = kq * 32 + kh * 16 + kk;
#pragma unroll
                for (int r = 0; r <= BATCH; ++r) acc[r] += wv[kk] * sil[r * D_MODEL + k]; } }
#pragma unroll
        for (int r = 0; r <= BATCH; ++r) *(LAS f32x4*)(red + (kq * (BATCH + 1) + r) * 64 + 4 * cq) = acc[r];
        __syncthreads();
        for (int o = tid; o < (BATCH + 1) * 64; o += NTHREADS) { const int r = o >> 6, c = o & 63; float s = p.b_ada[(size_t)l * N_ADA * D_MODEL + (it % nslab) * 64 + c];
#pragma unroll 8
            for (int q = 0; q < 32; ++q) s += red[(q * (BATCH + 1) + r) * 64 + c];
            p.ada[((size_t)l * (BATCH + 1) + r) * N_ADA * D_MODEL + (it % nslab) * 64 + c] = s; }
        __syncthreads();
    }
}
__device__ __forceinline__ void phase_wsb(const P& p) {
    const long n4 = (long)((DEPTH + 1) / 2) * B_GROUPS * CHUNK * CHUNK / 4;
    for (long i = (long)blockIdx.x * NTHREADS + tid_opaque(); i < n4; i += (long)gridDim.x * NTHREADS) { const f32x4 v = ((const f32x4*)p.b_spatial_w)[i]; uint2 o; o.x = pk_bf16(v[0], v[1]); o.y = pk_bf16(v[2], v[3]); ((uint2*)p.wsb)[i] = o; }
}
__device__ __forceinline__ void norm_token(const P& p, int which, int t, int lane, f32x4 (&v)[4], const f32x4 (&g4)[4], const f32x4 (&s4)[4], const f32x4 (&c4)[4]) {
    float ss = 0.f;
#pragma unroll
    for (int i = 0; i < 4; ++i) ss += (v[i][0] * v[i][0] + v[i][1] * v[i][1]) + (v[i][2] * v[i][2] + v[i][3] * v[i][3]);
    const float rs = 1.0f / sqrtf(wave_sum_fast(ss) * (1.0f / D_MODEL) + EPS);
    float hm = 0.f;
#pragma unroll
    for (int i = 0; i < 4; ++i) { const int d = 256 * i + 4 * lane;
        const f32x4 hh = v[i] * rs * g4[i] * (c4[i] + 1.0f) + s4[i]; uint2 o; o.x = pk_bf16(hh[0], hh[1]); o.y = pk_bf16(hh[2], hh[3]); *(uint2*)(p.h + (size_t)t * D_MODEL + d) = o;
        v[i] = hh; hm = fmaxf(hm, fmaxf(fmaxf(fabsf(hh[0]), fabsf(hh[1])), fmaxf(fabsf(hh[2]), fabsf(hh[3])))); }
    if (which) {
        hm = wave_max_fast(hm); const float inv = hm > 0.f ? 119.0f / hm : 0.f;
        unsigned wa[4], wb[4];
#pragma unroll
        for (int i = 0; i < 4; ++i) { wa[i] = 0u; wb[i] = 0u;
#pragma unroll
            for (int j = 0; j < 4; ++j) { const int q = (int)rintf(v[i][j] * inv); wb[i] |= (unsigned)(q & 15) << (4 * j); wa[i] |= (unsigned)(((q + 8) >> 4) & 15) << (4 * j); } }
        *(u32x2*)(p.hq + (size_t)t * D_MODEL + (lane & 3) * 128 + 8 * (lane >> 2)) = quad_gather16(wa[0], wa[1], wa[2], wa[3], lane);
        *(u32x2*)(p.hq + (size_t)t * D_MODEL + 512 + (lane & 3) * 128 + 8 * (lane >> 2)) = quad_gather16(wb[0], wb[1], wb[2], wb[3], lane);
        if (lane == 0) p.sh[t] = hm * (1.0f / 119.0f);
    }
}
__device__ __forceinline__ void phase_norm(const P& p, int l, int which, int ntok, bool from_input) {
    const int tid = tid_opaque(); const int lane = tid & 63, gw = blockIdx.x * (NTHREADS / 64) + (tid >> 6), ngw = gridDim.x * (NTHREADS / 64);
    const float* ng = (which ? p.norm2_g : p.norm1_g) + (size_t)l * D_MODEL;
    f32x4 g4[4];
#pragma unroll
    for (int i = 0; i < 4; ++i) g4[i] = *(const f32x4*)(ng + 256 * i + 4 * lane);
#define NORM_XLOAD(V, T) { const int tt = (T); \
        const float* xr = tt < NLAT ? p.x + (size_t)tt * D_MODEL : p.ctx + (size_t)(tt - NLAT) * D_MODEL; const bf16_t* xr16 = p.xb + (size_t)tt * D_MODEL; \
        _Pragma("unroll") for (int i = 0; i < 4; ++i) { \
            if (from_input) V[i] = *(const f32x4*)(xr + 256 * i + 4 * lane); \
            else { const u32x2 xw = *(const u32x2*)(xr16 + 256 * i + 4 * lane); V[i] = (f32x4){__uint_as_float(xw.x << 16), __uint_as_float(xw.x & 0xffff0000u), __uint_as_float(xw.y << 16), __uint_as_float(xw.y & 0xffff0000u)}; } } }
#define NORM_ADA(S4, C4, T) { const float* shp = ada_ptr(p, l, (T), which ? 3 : 0); const float* scp = ada_ptr(p, l, (T), which ? 4 : 1); \
        _Pragma("unroll") for (int i = 0; i < 4; ++i) { S4[i] = *(const f32x4*)(shp + 256 * i + 4 * lane); C4[i] = *(const f32x4*)(scp + 256 * i + 4 * lane); } }
    const int wpb = ngw / BATCH, b = gw % BATCH, j0 = gw / BATCH;
    if (j0 < wpb) {
        f32x4 s4[4], c4[4], vn[4];
        NORM_ADA(s4, c4, b * SEQ);
        NORM_XLOAD(vn, b * SEQ + j0);
        for (int j = j0; j < SEQ; j += wpb) {
            f32x4 v[4];
#pragma unroll
            for (int i = 0; i < 4; ++i) v[i] = vn[i];
            { const int jn = j + wpb < SEQ ? j + wpb : j0; NORM_XLOAD(vn, b * SEQ + jn); }
            norm_token(p, which, b * SEQ + j, lane, v, g4, s4, c4);
        }
    }
    if (ntok > NLAT && gw < ntok - NLAT) {
        f32x4 s4[4], c4[4];
        NORM_ADA(s4, c4, NLAT);
        for (int t = NLAT + gw; t < ntok; t += ngw) { f32x4 v[4]; NORM_XLOAD(v, t); norm_token(p, which, t, lane, v, g4, s4, c4); }
    }
#undef NORM_XLOAD
#undef NORM_ADA
}
__device__ __forceinline__ float bflo(unsigned w) { return __uint_as_float(w << 16); }
__device__ __forceinline__ float bfhi(unsigned w) { return __uint_as_float(w & 0xffff0000u); }
#define EM_LDS0 1024
#define EM_VROW 272
__device__ __forceinline__ void phase_even_mixer(const P& p, LAS unsigned char* lds0, int l) {
    LAS float* rstd = (LAS float*)(lds0 + EM_LDS0);
    LAS unsigned char* vt = lds0 + EM_LDS0 + 512;
    const int tid = tid_opaque(), lane = tid & 63, wave = tid >> 6, fr = lane & 15, g4 = lane >> 4;
    const int j = l / 2; const int nchunk = NT / CHUNK;
    for (int it = blockIdx.x; it < nchunk * B_GROUPS; it += gridDim.x) {
        const int g = it % B_GROUPS, t0 = (it / B_GROUPS) * CHUNK;
        const int q = tid >> 2, qt = tid & 3;
        const bf16_t* prow = p.bufA + (size_t)(t0 + q) * IN_W;
        { const f32x2 pv = *(const f32x2*)(p.vss + (size_t)(t0 + q) * 8 + 2 * qt); float ss = pv[0] + pv[1];
          ss += WRED_DPP(ss, 0xB1); ss += WRED_DPP(ss, 0x4E);
          if (qt == 0) rstd[q] = 1.0f / sqrtf(ss * (1.0f / MIX_W) + EPS); }
        __syncthreads();
        { const float rq = rstd[q];
#pragma unroll
          for (int h2 = 0; h2 < 2; ++h2) { const u32x4 w = *(const u32x4*)(prow + 4 * MIX_W + 64 * g + 16 * qt + 8 * h2);
#pragma unroll
              for (int k = 0; k < 4; ++k) { const int c = 16 * qt + 8 * h2 + 2 * k;
                  *(LAS bf16_t*)(vt + c * EM_VROW + q * 2) = (bf16_t)(pk_bf16(bflo(w[k]) * rq, 0.f) & 0xffffu);
                  *(LAS bf16_t*)(vt + (c + 1) * EM_VROW + q * 2) = (bf16_t)(pk_bf16(bfhi(w[k]) * rq, 0.f) & 0xffffu); } } }
        { const int t = t0 + q, pos = tok_pos(t), len = tok_len(t), cb = 64 * g + 16 * qt;
          const float* cw = p.a_conv_w + (size_t)j * A_CONV * MIX_W + cb;
#pragma unroll
          for (int h2 = 0; h2 < 2; ++h2) { float acc[8];
#pragma unroll
              for (int k = 0; k < 8; ++k) acc[k] = 0.f;
#pragma unroll
              for (int jj = 0; jj < A_CONV; ++jj) { const int qq = pos + jj - A_CONV / 2;
                  if (qq >= 0 && qq < len) { const bf16_t* rr = p.bufA + (size_t)(t + jj - A_CONV / 2) * IN_W + cb + 8 * h2;
                      const u32x4 ah = *(const u32x4*)rr, ac = *(const u32x4*)(rr + MIX_W);
                      const f32x4 w0 = *(const f32x4*)(cw + jj * MIX_W + 8 * h2), w1 = *(const f32x4*)(cw + jj * MIX_W + 8 * h2 + 4);
#pragma unroll
                      for (int k = 0; k < 4; ++k) { acc[2 * k] += (k < 2 ? w0[2 * k] : w1[2 * k - 4]) * bflo(ah[k]) * bflo(ac[k]); acc[2 * k + 1] += (k < 2 ? w0[2 * k + 1] : w1[2 * k - 3]) * bfhi(ah[k]) * bfhi(ac[k]); } } }
              const u32x4 ab = *(const u32x4*)(prow + 2 * MIX_W + cb + 8 * h2); u32x4 o;
#pragma unroll
              for (int k = 0; k < 4; ++k) o[k] = pk_bf16(bflo(ab[k]) * acc[2 * k], bfhi(ab[k]) * acc[2 * k + 1]);
              *(u32x4*)(p.h + (size_t)t * (2 * MIX_W) + cb + 8 * h2) = o; } }
        __syncthreads();
        { const int pp = 16 * wave + fr; const bf16_t* wrow = p.wsb + (((size_t)j * B_GROUPS + g) * CHUNK + pp) * CHUNK + 8 * g4;
          bf16x8 bw[4];
#pragma unroll
          for (int s = 0; s < 4; ++s) bw[s] = *(const bf16x8*)(wrow + 32 * s);
          f32x4 acc[4];
#pragma unroll
          for (int cb = 0; cb < 4; ++cb) { acc[cb] = (f32x4){0.f, 0.f, 0.f, 0.f};
#pragma unroll
              for (int s = 0; s < 4; ++s) { const bf16x8 av = *(const LAS bf16x8*)(vt + (16 * cb + fr) * EM_VROW + (4 * s + g4) * 16); acc[cb] = __builtin_amdgcn_mfma_f32_16x16x32_bf16(av, bw[s], acc[cb], 0, 0, 0); } }
          const int t = t0 + pp; const float bs = p.b_spatial_b[((size_t)j * B_GROUPS + g) * CHUNK + pp];
#pragma unroll
          for (int cb = 0; cb < 4; ++cb) { const int c = 64 * g + 16 * cb + 4 * g4; const f32x4 vg = *(const f32x4*)(p.b_vnorm_g + (size_t)j * MIX_W + c);
              const uint2 gu = *(const uint2*)(p.bufA + (size_t)t * IN_W + 3 * MIX_W + c); const f32x4 s4 = acc[cb] * vg + bs;
              uint2 o; o.x = pk_bf16(bflo(gu.x) * s4[0], bfhi(gu.x) * s4[1]); o.y = pk_bf16(bflo(gu.y) * s4[2], bfhi(gu.y) * s4[3]);
              *(uint2*)(p.h + (size_t)t * (2 * MIX_W) + MIX_W + c) = o; } }
        __syncthreads();
    }
}
#define CF_T 32
#define CF_ROWS (CF_T + C_CONV - 1)
__device__ __forceinline__ void phase_conformer(const P& p, LAS unsigned char* lds0, int l) {
    LAS bf16_t* ys = (LAS bf16_t*)(lds0 + 1024);
    LAS float* part = (LAS float*)(lds0 + 1024 + CF_ROWS * MIX_W * 2);
    const int tid = tid_opaque(), lane = tid & 63, wave = tid >> 6, j = l / 2;
    float wc[C_CONV];
#pragma unroll
    for (int k = 0; k < C_CONV; ++k) wc[k] = p.c_conv_w[((size_t)j * C_CONV + k) * MIX_W + tid];
    const float bias = p.c_conv_b[(size_t)j * MIX_W + tid], gn = p.c_norm_g[(size_t)j * MIX_W + tid];
    for (int it = blockIdx.x; it < NLAT / CF_T; it += gridDim.x) {
        const int t0 = it * CF_T, pos0 = t0 % SEQ;
        for (int c = tid; c < CF_ROWS * (MIX_W / 8); c += NTHREADS) { const int row = c / (MIX_W / 8), ch = c % (MIX_W / 8), pos = pos0 + row - C_CONV / 2;
            u32x4 o = (u32x4){0u, 0u, 0u, 0u};
            if (pos >= 0 && pos < SEQ) { const bf16_t* rr = p.bufA + (size_t)(t0 + row - C_CONV / 2) * IN_W + 8 * ch; const u32x4 a = *(const u32x4*)rr, gte = *(const u32x4*)(rr + MIX_W);
#pragma unroll
                for (int k = 0; k < 4; ++k) o[k] = pk_bf16(bflo(a[k]) * __builtin_amdgcn_rcpf(1.0f + __expf(-bflo(gte[k]))), bfhi(a[k]) * __builtin_amdgcn_rcpf(1.0f + __expf(-bfhi(gte[k])))); }
            *(LAS u32x4*)((LAS unsigned char*)ys + row * (MIX_W * 2) + ch * 16) = o; }
        __syncthreads();
        float yv[CF_ROWS];
#pragma unroll
        for (int r = 0; r < CF_ROWS; ++r) yv[r] = __uint_as_float((unsigned)ys[r * MIX_W + tid] << 16);
        float outv[CF_T];
#pragma unroll
        for (int t = 0; t < CF_T; ++t) { float a = bias;
#pragma unroll
            for (int k = 0; k < C_CONV; ++k) a += wc[k] * yv[t + k];
            outv[t] = a; }
        { static_assert(CF_T == 32, "transposed reduction below is written for 32 tokens");
          float a16[16], a8[8], a4[4], a2[2];
#pragma unroll
          for (int i = 0; i < 16; ++i) { auto rr = __builtin_amdgcn_permlane32_swap(__float_as_uint(outv[i] * outv[i]), __float_as_uint(outv[i + 16] * outv[i + 16]), false, false); a16[i] = __uint_as_float(rr[0]) + __uint_as_float(rr[1]); }
#pragma unroll
          for (int i = 0; i < 8; ++i) { auto rr = __builtin_amdgcn_permlane16_swap(__float_as_uint(a16[i]), __float_as_uint(a16[i + 8]), false, false); a8[i] = __uint_as_float(rr[0]) + __uint_as_float(rr[1]); }
          const bool b3 = lane & 8, b2 = lane & 4, b1 = lane & 2;
#pragma unroll
          for (int i = 0; i < 4; ++i) { const float keep = b3 ? a8[i + 4] : a8[i], send = b3 ? a8[i] : a8[i + 4]; a4[i] = keep + WRED_DPP(send, 0x128); }
#pragma unroll
          for (int i = 0; i < 2; ++i) { const float keep = b2 ? a4[i + 2] : a4[i], send = b2 ? a4[i] : a4[i + 2]; const float s1 = WRED_DPP(send, 0x141); a2[i] = keep + WRED_DPP(s1, 0x1B); }
          float a1; { const float keep = b1 ? a2[1] : a2[0], send = b1 ? a2[0] : a2[1]; a1 = keep + WRED_DPP(send, 0x4E); }
          a1 += WRED_DPP(a1, 0xB1);
          if ((lane & 1) == 0) part[((lane >> 1) & 31) * 8 + wave] = a1; }
        __syncthreads();
        if (tid < CF_T) { float s = 0.f;
#pragma unroll
            for (int w = 0; w < 8; ++w) s += part[tid * 8 + w];
            part[CF_T * 8 + tid] = 1.0f / sqrtf(s * (1.0f / MIX_W) + EPS); }
        __syncthreads();
#pragma unroll
        for (int t = 0; t < CF_T; ++t) {
            const float v = outv[t] * part[CF_T * 8 + t] * gn; const float y = v * __builtin_amdgcn_rcpf(1.0f + __expf(-v));
            p.h[(size_t)(t0 + t) * (2 * MIX_W) + tid] = (bf16_t)(pk_bf16(y, 0.f) & 0xffffu); }
        __syncthreads();
    }
}


template <int CTRL> __device__ __forceinline__ float dpp_f(float v) { return __int_as_float(__builtin_amdgcn_update_dpp(0, __float_as_int(v), CTRL, 0xF, 0xF, true)); }
__device__ __forceinline__ float lane_xor1(float v) { return dpp_f<0xB1>(v); }
__device__ __forceinline__ float lane_xor2(float v) { return dpp_f<0x4E>(v); }
__device__ __forceinline__ float lane_xor4(float v) { return dpp_f<0x1B>(dpp_f<0x141>(v)); }
__device__ __forceinline__ float lane_xor8(float v) { return dpp_f<0x128>(v); }
__device__ __forceinline__ float pair32(float a, float b) { auto rr = __builtin_amdgcn_permlane32_swap(__float_as_uint(a), __float_as_uint(b), false, false); return __uint_as_float(rr[0]) + __uint_as_float(rr[1]); }
__device__ __forceinline__ float pair16(float a, float b) { auto rr = __builtin_amdgcn_permlane16_swap(__float_as_uint(a), __float_as_uint(b), false, false); return __uint_as_float(rr[0]) + __uint_as_float(rr[1]); }
#define G_ID(w, i) (((w)[(i) >> 1] >> (16 * ((i) & 1))) & 0xffffu)
__device__ __forceinline__ void g_rows(const unsigned char* base, const u32x4& ia, const u32x4& ib, u32x4 (&row)[16]) {
    unsigned w[8] = {ia[0], ia[1], ia[2], ia[3], ib[0], ib[1], ib[2], ib[3]};
#pragma unroll
    for (int i = 0; i < 16; ++i) row[i] = *(const u32x4*)(base + (size_t)G_ID(w, i) * 128);
}
__device__ __forceinline__ void g_dots_compute(const u32x4 (&r0)[16], const u32x4& h0, const u32x4& h1, int q, float& pdA, float& pdB) {
    f32x2 hv[8];
#pragma unroll
    for (int k = 0; k < 4; ++k) { hv[k] = (f32x2){bflo(h0[k]), bfhi(h0[k])}; hv[4 + k] = (f32x2){bflo(h1[k]), bfhi(h1[k])}; }
    float s[16];
#pragma unroll
    for (int i = 0; i < 16; ++i) { f32x2 a = (f32x2){0.f, 0.f};
#pragma unroll
        for (int k = 0; k < 4; ++k) { a = __builtin_amdgcn_cvt_pk_f32_fp8((int)r0[i][k], false) * hv[2 * k] + a; a = __builtin_amdgcn_cvt_pk_f32_fp8((int)r0[i][k], true) * hv[2 * k + 1] + a; }
        s[i] = a[0] + a[1]; }
    const bool qb2 = q & 4, qb1 = q & 2, qb0 = q & 1;
    float u8[8], u4[4];
#pragma unroll
    for (int m = 0; m < 2; ++m)
#pragma unroll
        for (int i = 0; i < 4; ++i) { const float keep = qb2 ? s[8 * m + i + 4] : s[8 * m + i], send = qb2 ? s[8 * m + i] : s[8 * m + i + 4]; u8[4 * m + i] = keep + lane_xor4(send); }
#pragma unroll
    for (int m = 0; m < 2; ++m)
#pragma unroll
        for (int i = 0; i < 2; ++i) { const float keep = qb1 ? u8[4 * m + i + 2] : u8[4 * m + i], send = qb1 ? u8[4 * m + i] : u8[4 * m + i + 2]; u4[2 * m + i] = keep + lane_xor2(send); }
    { const float keep = qb0 ? u4[1] : u4[0], send = qb0 ? u4[0] : u4[1]; pdA = keep + lane_xor1(send); }
    { const float keep = qb0 ? u4[3] : u4[2], send = qb0 ? u4[2] : u4[3]; pdB = keep + lane_xor1(send); }
}
__device__ __forceinline__ void phase_gather_dots(const P& p, int l, int ntok) {
    const int tid = tid_opaque(), lane = tid & 63, wave = tid >> 6, r = lane >> 3, q = lane & 7;
    const int nxg = (gridDim.x % 8 == 0) ? 8 : 1, xg = blockIdx.x % nxg, gwx = (blockIdx.x / nxg) * (NTHREADS / 64) + wave, ngwx = (gridDim.x / nxg) * (NTHREADS / 64);
    float* pd = p.bufB;
    for (int sl = xg; sl < 8; sl += nxg) {
        const unsigned char* Us = p.u8 + ((size_t)(l * 8 + sl) * PEER_EXPERTS) * 128 + 16 * q;
        const unsigned short* ip = p.pidx16 + 16 * r; const bf16_t* hp = p.h + 128 * sl + 16 * q;
        int t = gwx; if (t >= ntok) continue;
        u32x4 ra[16], rb[16], ia1, ib1, ia2, ib2, h0c, h1c, h0n, h1n;
        { const u32x4 ia0 = *(const u32x4*)(ip + (size_t)t * NPAIR), ib0 = *(const u32x4*)(ip + (size_t)t * NPAIR + 8); h0c = *(const u32x4*)(hp + (size_t)t * D_MODEL); h1c = *(const u32x4*)(hp + (size_t)t * D_MODEL + 8); g_rows(Us, ia0, ib0, ra); }
        int t1 = t + ngwx; { const int tc = t1 < ntok ? t1 : t; ia1 = *(const u32x4*)(ip + (size_t)tc * NPAIR); ib1 = *(const u32x4*)(ip + (size_t)tc * NPAIR + 8); }
#define GD_STEP(RC, RN) { \
            { const int t1c = t1 < ntok ? t1 : t; g_rows(Us, ia1, ib1, RN); h0n = *(const u32x4*)(hp + (size_t)t1c * D_MODEL); h1n = *(const u32x4*)(hp + (size_t)t1c * D_MODEL + 8); } \
            const int t2 = t1 + ngwx; { const int t2c = t2 < ntok ? t2 : t; ia2 = *(const u32x4*)(ip + (size_t)t2c * NPAIR); ib2 = *(const u32x4*)(ip + (size_t)t2c * NPAIR + 8); } \
            float pdA, pdB; g_dots_compute(RC, h0c, h1c, q, pdA, pdB); \
            pd[((size_t)sl * NT + t) * NPAIR + 16 * r + q] = pdA; pd[((size_t)sl * NT + t) * NPAIR + 16 * r + 8 + q] = pdB; \
            h0c = h0n; h1c = h1n; ia1 = ia2; ib1 = ib2; t = t1; t1 = t2; }
        while (t < ntok) { GD_STEP(ra, rb); if (t >= ntok) break; GD_STEP(rb, ra); }
#undef GD_STEP
    }
}
__device__ __forceinline__ void phase_gather_w(const P& p, int l, int ntok) {
    const float* pd = p.bufB; float* pw = (float*)p.bufA;
    const float* su = p.su + (size_t)l * PEER_EXPERTS; const float* svs = p.svs + (size_t)l * PEER_EXPERTS;
    const long n = (long)ntok * NPAIR;
    for (long i = (long)blockIdx.x * NTHREADS + tid_opaque(); i < n; i += (long)gridDim.x * NTHREADS) {
        float d = 0.f;
#pragma unroll
        for (int sl = 0; sl < 8; ++sl) d += pd[(size_t)sl * NT * NPAIR + i];
        const int e = p.pidx16[i]; pw[i] = p.pg[i] * gelu_fast(d * su[e]) * svs[e];
    }
}
__device__ __forceinline__ void g_out_compute(const u32x4 (&r0)[16], const f32x4 (&wv)[4], int r, f32x2& dd) {
    f32x2 acc[8];
#pragma unroll
    for (int k = 0; k < 8; ++k) acc[k] = (f32x2){0.f, 0.f};
#pragma unroll
    for (int i = 0; i < 16; ++i) { const float w = wv[i >> 2][i & 3]; const f32x2 w2 = (f32x2){w, w};
#pragma unroll
        for (int k = 0; k < 4; ++k) { acc[2 * k] = __builtin_amdgcn_cvt_pk_f32_fp8((int)r0[i][k], false) * w2 + acc[2 * k]; acc[2 * k + 1] = __builtin_amdgcn_cvt_pk_f32_fp8((int)r0[i][k], true) * w2 + acc[2 * k + 1]; } }
    float b8[8], c4[4];
#pragma unroll
    for (int n = 0; n < 8; ++n) b8[n] = pair32(acc[n >> 1][n & 1], acc[(n + 8) >> 1][n & 1]);
#pragma unroll
    for (int n = 0; n < 4; ++n) c4[n] = pair16(b8[n], b8[n + 4]);
    const bool rb0 = r & 1;
    { const float keep = rb0 ? c4[2] : c4[0], send = rb0 ? c4[0] : c4[2]; dd[0] = keep + lane_xor8(send); }
    { const float keep = rb0 ? c4[3] : c4[1], send = rb0 ? c4[1] : c4[3]; dd[1] = keep + lane_xor8(send); }
}
__device__ __forceinline__ void phase_gather_out(const P& p, int l, int ntok) {
    const int tid = tid_opaque(), lane = tid & 63, wave = tid >> 6, r = lane >> 3, q = lane & 7;
    const int nxg = (gridDim.x % 8 == 0) ? 8 : 1, xg = blockIdx.x % nxg, gwx = (blockIdx.x / nxg) * (NTHREADS / 64) + wave, ngwx = (gridDim.x / nxg) * (NTHREADS / 64);
    const bool last = l == DEPTH - 1;
    for (int sl = xg; sl < 8; sl += nxg) {
        const unsigned char* Vs = p.v8 + ((size_t)(l * 8 + sl) * PEER_EXPERTS) * 128 + 16 * q;
        const unsigned short* ip = p.pidx16 + 16 * r; const float* wp = (const float*)p.bufA + 16 * r;
        const int dof = 128 * sl + 16 * q + 2 * r;
        int t = gwx; if (t >= ntok) continue;
        u32x4 ra[16], rb[16], ia1, ib1, ia2, ib2; f32x4 wc[4], wn[4]; f32x2 gc, xc, gn, xn;
        { const u32x4 ia0 = *(const u32x4*)(ip + (size_t)t * NPAIR), ib0 = *(const u32x4*)(ip + (size_t)t * NPAIR + 8);
#pragma unroll
          for (int k = 0; k < 4; ++k) wc[k] = *(const f32x4*)(wp + (size_t)t * NPAIR + 4 * k);
          gc = *(const f32x2*)(ada_ptr(p, l, t, 5) + dof); xc = *(const f32x2*)(p.xcur + (size_t)t * D_MODEL + dof); g_rows(Vs, ia0, ib0, ra); }
        int t1 = t + ngwx; { const int tc = t1 < ntok ? t1 : t; ia1 = *(const u32x4*)(ip + (size_t)tc * NPAIR); ib1 = *(const u32x4*)(ip + (size_t)tc * NPAIR + 8); }
#define GO_STEP(RC, RN) { \
            { const int t1c = t1 < ntok ? t1 : t; g_rows(Vs, ia1, ib1, RN); _Pragma("unroll") for (int k = 0; k < 4; ++k) wn[k] = *(const f32x4*)(wp + (size_t)t1c * NPAIR + 4 * k); \
                gn = *(const f32x2*)(ada_ptr(p, l, t1c, 5) + dof); xn = *(const f32x2*)(p.xcur + (size_t)t1c * D_MODEL + dof); } \
            const int t2 = t1 + ngwx; { const int t2c = t2 < ntok ? t2 : t; ia2 = *(const u32x4*)(ip + (size_t)t2c * NPAIR); ib2 = *(const u32x4*)(ip + (size_t)t2c * NPAIR + 8); } \
            f32x2 dd; g_out_compute(RC, wc, r, dd); \
            *(f32x2*)((last ? p.out : p.xcur) + (size_t)t * D_MODEL + dof) = xc + gc * dd; \
            _Pragma("unroll") for (int k = 0; k < 4; ++k) wc[k] = wn[k]; gc = gn; xc = xn; ia1 = ia2; ib1 = ib2; t = t1; t1 = t2; }
        while (t < ntok) { GO_STEP(ra, rb); if (t >= ntok) break; GO_STEP(rb, ra); }
#undef GO_STEP
    }
}


#define FP4_TOP 6.0f
#ifdef DBG_FP4
#define DBG_SCALE(ov) { const unsigned _c = p.bar[DBG_WORD]; if (last && _c) ov = ov * (1.0f + 0.1f * (1.0f + log10f((float)_c))); }
#else
#define DBG_SCALE(ov)
#endif
__device__ __forceinline__ void convert4_finish(const f32x4 (&v)[4], unsigned char* dst, size_t slice_stride, float* scale_out, int lane, unsigned* dbgw) {
    float m = 0.f;
#pragma unroll
    for (int i = 0; i < 4; ++i) m = fmaxf(m, fmaxf(fmaxf(fabsf(v[i][0]), fabsf(v[i][1])), fmaxf(fabsf(v[i][2]), fabsf(v[i][3]))));
    m = wave_max(m);
    const float inv = m > 0.f ? FP4_TOP / m : 0.f;
    unsigned wq[4];
#pragma unroll
    for (int i = 0; i < 4; ++i) { unsigned w = 0u; w = __builtin_amdgcn_cvt_scalef32_pk_fp4_f32(w, v[i][0] * inv, v[i][1] * inv, 1.0f, 0); w = __builtin_amdgcn_cvt_scalef32_pk_fp4_f32(w, v[i][2] * inv, v[i][3] * inv, 1.0f, 1);
        wq[i] = w & 0xffffu;
#ifdef DBG_FP4
        { const f32x2 d01 = __builtin_amdgcn_cvt_scalef32_pk_f32_fp4(w, 1.0f, 0), d23 = __builtin_amdgcn_cvt_scalef32_pk_f32_fp4(w, 1.0f, 1);
          const float e0 = fabsf(d01[0] - v[i][0] * inv), e1 = fabsf(d01[1] - v[i][1] * inv), e2 = fabsf(d23[0] - v[i][2] * inv), e3 = fabsf(d23[1] - v[i][3] * inv);
          if (!(e0 <= 1.01f && e1 <= 1.01f && e2 <= 1.01f && e3 <= 1.01f)) atomicAdd(dbgw, 1u); }
#endif
        }
    *(u32x2*)(dst + (size_t)(lane & 3) * slice_stride + 8 * (lane >> 2)) = quad_gather16(wq[0], wq[1], wq[2], wq[3], lane);
    if (lane == 0) *scale_out = m > 0.f ? m / FP4_TOP : 0.f;
}
#define I4_CLIP 2.5f
__device__ __forceinline__ void convert_i4_finish(const f32x4 (&v)[4], unsigned char* dst, size_t slice_stride, float* scale_out, int lane) {
    float ss = 0.f;
#pragma unroll
    for (int i = 0; i < 4; ++i) ss += (v[i][0] * v[i][0] + v[i][1] * v[i][1]) + (v[i][2] * v[i][2] + v[i][3] * v[i][3]);
    const float rms = sqrtf(wave_sum(ss) * (1.0f / D_MODEL));
    const float inv = rms > 0.f ? 7.0f / (I4_CLIP * rms) : 0.f;
    unsigned wq[4];
#pragma unroll
    for (int i = 0; i < 4; ++i) { wq[i] = 0u;
#pragma unroll
        for (int j = 0; j < 4; ++j) { const int q = (int)rintf(fminf(fmaxf(v[i][j] * inv, -7.0f), 7.0f)); wq[i] |= (unsigned)(q & 15) << (4 * j); } }
    *(u32x2*)(dst + (size_t)(lane & 3) * slice_stride + 8 * (lane >> 2)) = quad_gather16(wq[0], wq[1], wq[2], wq[3], lane);
    if (lane == 0) *scale_out = I4_CLIP * rms * (1.0f / 7.0f);
}
__device__ __forceinline__ void phase_peer_tables4(const P& p) {
    const int tid = tid_opaque(); const int lane = tid & 63, gw = blockIdx.x * (NTHREADS / 64) + (tid >> 6), ngw = gridDim.x * (NTHREADS / 64);
    const int R = DEPTH * PEER_EXPERTS;
    for (int r0 = gw; r0 < R; r0 += 4 * ngw) {
        f32x4 v[4][4];
#pragma unroll
        for (int k = 0; k < 4; ++k) { const int row = r0 + k * ngw; if (row < R) { const float* srcp = p.peer_u + (size_t)row * D_MODEL;
#pragma unroll
            for (int i = 0; i < 4; ++i) v[k][i] = ((const f32x4*)srcp)[i * 64 + lane]; } }
#pragma unroll
        for (int k = 0; k < 4; ++k) { const int row = r0 + k * ngw; if (row < R)
            convert_i4_finish(v[k], p.u8 + ((size_t)(row / PEER_EXPERTS) * 4 * PEER_EXPERTS + (row % PEER_EXPERTS)) * 128, (size_t)PEER_EXPERTS * 128, p.su + row, lane); }
    }
    for (int r0 = gw; r0 < R; r0 += 4 * ngw) {
        f32x4 v[4][4];
#pragma unroll
        for (int k = 0; k < 4; ++k) { const int row = r0 + k * ngw; if (row < R) { const float* srcp = p.peer_v + (size_t)row * D_MODEL;
#pragma unroll
            for (int i = 0; i < 4; ++i) v[k][i] = ((const f32x4*)srcp)[i * 64 + lane]; } }
#pragma unroll
        for (int k = 0; k < 4; ++k) { const int row = r0 + k * ngw; if (row < R)
            convert4_finish(v[k], p.v8 + ((size_t)(row / PEER_EXPERTS) * 4 * PEER_EXPERTS + (row % PEER_EXPERTS)) * 128, (size_t)PEER_EXPERTS * 128, p.svs + row, lane, p.bar + DBG_WORD); }
    }
}
struct G4Place { int nsl, sl0, tsub, ntsub, gwx, ngwx; };
__device__ __forceinline__ G4Place g4_place(int wave) {
    G4Place g; const int nxg = (gridDim.x % 8 == 0) ? 8 : 1, xg = blockIdx.x % nxg;
    g.gwx = (blockIdx.x / nxg) * (NTHREADS / 64) + wave; g.ngwx = (gridDim.x / nxg) * (NTHREADS / 64);
    if (nxg == 8) { g.nsl = 1; g.sl0 = xg & 3; g.tsub = xg >> 2; g.ntsub = 2; } else { g.nsl = 4; g.sl0 = 0; g.tsub = 0; g.ntsub = 1; }
    return g; }
__device__ __forceinline__ void g4_dots_compute(const u32x4 (&r0)[16], const u32x4& ha, const u32x4& hb, int q, float& pdA, float& pdB) {
    float s[16];
#pragma unroll
    for (int i = 0; i < 16; ++i) { int a = 0, c2 = 0;
#pragma unroll
        for (int k = 0; k < 4; ++k) { a = __builtin_amdgcn_sdot8((int)r0[i][k], (int)ha[k], a, false); c2 = __builtin_amdgcn_sdot8((int)r0[i][k], (int)hb[k], c2, false); }
        s[i] = (float)(16 * a + c2); }
    const bool qb2 = q & 4, qb1 = q & 2, qb0 = q & 1;
    float u8[8], u4[4];
#pragma unroll
    for (int m = 0; m < 2; ++m)
#pragma unroll
        for (int i = 0; i < 4; ++i) { const float keep = qb2 ? s[8 * m + i + 4] : s[8 * m + i], send = qb2 ? s[8 * m + i] : s[8 * m + i + 4]; u8[4 * m + i] = keep + lane_xor4(send); }
#pragma unroll
    for (int m = 0; m < 2; ++m)
#pragma unroll
        for (int i = 0; i < 2; ++i) { const float keep = qb1 ? u8[4 * m + i + 2] : u8[4 * m + i], send = qb1 ? u8[4 * m + i] : u8[4 * m + i + 2]; u4[2 * m + i] = keep + lane_xor2(send); }
    { const float keep = qb0 ? u4[1] : u4[0], send = qb0 ? u4[0] : u4[1]; pdA = keep + lane_xor1(send); }
    { const float keep = qb0 ? u4[3] : u4[2], send = qb0 ? u4[2] : u4[3]; pdB = keep + lane_xor1(send); }
}
__device__ __forceinline__ void phase_gather4_dots(const P& p, int l, int ntok) {
    const int tid = tid_opaque(), lane = tid & 63, wave = tid >> 6, r = lane >> 3, q = lane & 7;
    const G4Place gp = g4_place(wave);
    float* pd = p.bufB;
    for (int si = 0; si < gp.nsl; ++si) { const int sl = gp.sl0 + si;
        const unsigned char* Us = p.u8 + ((size_t)(l * 4 + sl) * PEER_EXPERTS) * 128 + 16 * q;
        const unsigned short* ip = p.pidx16 + 16 * r; const unsigned char* hp = p.hq + 128 * sl + 16 * q;
        const int step = gp.ntsub * gp.ngwx; int t = gp.tsub + gp.ntsub * gp.gwx; if (t >= ntok) continue;
        u32x4 ra[16], rb[16], ia1, ib1, ia2, ib2, hac, hbc, han, hbn;
        { const u32x4 ia0 = *(const u32x4*)(ip + (size_t)t * NPAIR), ib0 = *(const u32x4*)(ip + (size_t)t * NPAIR + 8);
          hac = *(const u32x4*)(hp + (size_t)t * D_MODEL); hbc = *(const u32x4*)(hp + (size_t)t * D_MODEL + 512);
          g_rows(Us, ia0, ib0, ra); }
        int t1 = t + step; { const int tc = t1 < ntok ? t1 : t; ia1 = *(const u32x4*)(ip + (size_t)tc * NPAIR); ib1 = *(const u32x4*)(ip + (size_t)tc * NPAIR + 8); }
#define G4D_STEP(RC, RN) { \
            { const int t1c = t1 < ntok ? t1 : t; g_rows(Us, ia1, ib1, RN); han = *(const u32x4*)(hp + (size_t)t1c * D_MODEL); hbn = *(const u32x4*)(hp + (size_t)t1c * D_MODEL + 512); } \
            const int t2 = t1 + step; { const int t2c = t2 < ntok ? t2 : t; ia2 = *(const u32x4*)(ip + (size_t)t2c * NPAIR); ib2 = *(const u32x4*)(ip + (size_t)t2c * NPAIR + 8); } \
            float pdA, pdB; g4_dots_compute(RC, hac, hbc, q, pdA, pdB); \
            pd[((size_t)sl * NT + t) * NPAIR + 16 * r + q] = pdA; pd[((size_t)sl * NT + t) * NPAIR + 16 * r + 8 + q] = pdB; \
            hac = han; hbc = hbn; ia1 = ia2; ib1 = ib2; t = t1; t1 = t2; }
        while (t < ntok) { G4D_STEP(ra, rb); if (t >= ntok) break; G4D_STEP(rb, ra); }
#undef G4D_STEP
    }
}
__device__ __forceinline__ void phase_gather4_w(const P& p, int l, int ntok) {
    const float* pd = p.bufB; unsigned* pw = (unsigned*)p.bufA;
    const float* su = p.su + (size_t)l * PEER_EXPERTS; const float* svs = p.svs + (size_t)l * PEER_EXPERTS;
    const long n4 = (long)ntok * NPAIR / 4;
    for (long i4 = (long)blockIdx.x * NTHREADS + tid_opaque(); i4 < n4; i4 += (long)gridDim.x * NTHREADS) {
        const long i = 4 * i4;
        f32x4 d = *(const f32x4*)(pd + i);
#pragma unroll
        for (int sl = 1; sl < 4; ++sl) d += *(const f32x4*)(pd + (size_t)sl * NT * NPAIR + i);
        const u32x2 ev = *(const u32x2*)(p.pidx16 + i); const f32x4 g = *(const f32x4*)(p.pg + i); const float sh = p.sh[i / NPAIR];
        const int e[4] = {(int)(ev.x & 0xffffu), (int)(ev.x >> 16), (int)(ev.y & 0xffffu), (int)(ev.y >> 16)};
        float sue[4], sve[4];
#pragma unroll
        for (int k = 0; k < 4; ++k) { sue[k] = su[e[k]]; sve[k] = svs[e[k]]; }
        u32x4 o;
#pragma unroll
        for (int k = 0; k < 4; ++k) { const float w = g[k] * gelu_fast(d[k] * sue[k] * sh) * sve[k];
            const _Float16 h = (_Float16)fminf(fmaxf(w * 1024.0f, -60000.0f), 60000.0f); const unsigned hb = (unsigned)__builtin_bit_cast(unsigned short, h);
            o[k] = hb | (hb << 16); }
        *(u32x4*)(pw + i) = o;
    }
}
typedef _Float16 f16v8 __attribute__((ext_vector_type(8)));
__device__ __forceinline__ f16v2 pair32h(f16v2 a, f16v2 b) { auto rr = __builtin_amdgcn_permlane32_swap(__builtin_bit_cast(unsigned, a), __builtin_bit_cast(unsigned, b), false, false);
    unsigned x = rr[0], y = rr[1]; asm volatile("" : "+v"(x), "+v"(y)); return __builtin_bit_cast(f16v2, x) + __builtin_bit_cast(f16v2, y); }
__device__ __forceinline__ f16v2 pair16h(f16v2 a, f16v2 b) { auto rr = __builtin_amdgcn_permlane16_swap(__builtin_bit_cast(unsigned, a), __builtin_bit_cast(unsigned, b), false, false);
    unsigned x = rr[0], y = rr[1]; asm volatile("" : "+v"(x), "+v"(y)); return __builtin_bit_cast(f16v2, x) + __builtin_bit_cast(f16v2, y); }
__device__ __forceinline__ void g4_out_compute(const u32x4 (&r0)[16], const u32x4 (&wv)[4], int r, f32x4& dd) {
    f16v2 acc16[16];
#pragma unroll
    for (int k = 0; k < 16; ++k) acc16[k] = (f16v2){(_Float16)0.f, (_Float16)0.f};
#pragma unroll
    for (int i = 0; i < 16; ++i) { const f16v8 w8 = __builtin_bit_cast(f16v8, wv[i >> 2]);
        const f16v2 w2 = (i & 3) == 0 ? __builtin_shufflevector(w8, w8, 0, 1) : (i & 3) == 1 ? __builtin_shufflevector(w8, w8, 2, 3) : (i & 3) == 2 ? __builtin_shufflevector(w8, w8, 4, 5) : __builtin_shufflevector(w8, w8, 6, 7);
#pragma unroll
        for (int k = 0; k < 4; ++k) {
            acc16[4 * k + 0] = __builtin_amdgcn_cvt_scalef32_pk_f16_fp4(r0[i][k], 1.0f, 0) * w2 + acc16[4 * k + 0]; acc16[4 * k + 1] = __builtin_amdgcn_cvt_scalef32_pk_f16_fp4(r0[i][k], 1.0f, 1) * w2 + acc16[4 * k + 1];
            acc16[4 * k + 2] = __builtin_amdgcn_cvt_scalef32_pk_f16_fp4(r0[i][k], 1.0f, 2) * w2 + acc16[4 * k + 2]; acc16[4 * k + 3] = __builtin_amdgcn_cvt_scalef32_pk_f16_fp4(r0[i][k], 1.0f, 3) * w2 + acc16[4 * k + 3]; } }
    f16v2 p8[8], q4[4];
#pragma unroll
    for (int j = 0; j < 8; ++j) p8[j] = pair32h(acc16[j], acc16[j + 8]);
#pragma unroll
    for (int j = 0; j < 4; ++j) q4[j] = pair16h(p8[j], p8[j + 4]);
    const bool rb0 = r & 1;
#pragma unroll
    for (int j = 0; j < 2; ++j) { const unsigned keep = __builtin_bit_cast(unsigned, rb0 ? q4[j + 2] : q4[j]), send = __builtin_bit_cast(unsigned, rb0 ? q4[j] : q4[j + 2]);
        unsigned got = (unsigned)__builtin_amdgcn_update_dpp(0, (int)send, 0x128, 0xF, 0xF, true), kp = keep; asm volatile("" : "+v"(got), "+v"(kp));
        const f16v2 s2 = __builtin_bit_cast(f16v2, kp) + __builtin_bit_cast(f16v2, got);
        dd[2 * j] = (float)s2[0] * (1.0f / 1024.0f); dd[2 * j + 1] = (float)s2[1] * (1.0f / 1024.0f); }
}
__device__ __forceinline__ void phase_gather4_out(const P& p, int l, int ntok) {
    const int tid = tid_opaque(), lane = tid & 63, wave = tid >> 6, r = lane >> 3, q = lane & 7;
    const G4Place gp = g4_place(wave);
    const bool last = l == DEPTH - 1;
    for (int si = 0; si < gp.nsl; ++si) { const int sl = gp.sl0 + si;
        const unsigned char* Vs = p.v8 + ((size_t)(l * 4 + sl) * PEER_EXPERTS) * 128 + 16 * q;
        const unsigned short* ip = p.pidx16 + 16 * r; const unsigned* wp = (const unsigned*)p.bufA + 16 * r;
        const int dof = 256 * sl + 32 * q + 4 * r;
        const int step = gp.ntsub * gp.ngwx; int t = gp.tsub + gp.ntsub * gp.gwx; if (t >= ntok) continue;
        u32x4 ra[16], rb[16], ia1, ib1, ia2, ib2, wc[4], wn[4]; f32x4 gc, gn; u32x2 xc, xn;
        { const u32x4 ia0 = *(const u32x4*)(ip + (size_t)t * NPAIR), ib0 = *(const u32x4*)(ip + (size_t)t * NPAIR + 8);
#pragma unroll
          for (int k = 0; k < 4; ++k) wc[k] = *(const u32x4*)(wp + (size_t)t * NPAIR + 4 * k);
          gc = *(const f32x4*)(ada_ptr(p, l, t, 5) + dof); xc = *(const u32x2*)(p.xb + (size_t)t * D_MODEL + dof); g_rows(Vs, ia0, ib0, ra); }
        int t1 = t + step; { const int tc = t1 < ntok ? t1 : t; ia1 = *(const u32x4*)(ip + (size_t)tc * NPAIR); ib1 = *(const u32x4*)(ip + (size_t)tc * NPAIR + 8); }
#define G4O_STEP(RC, RN) { \
            { const int t1c = t1 < ntok ? t1 : t; g_rows(Vs, ia1, ib1, RN); _Pragma("unroll") for (int k = 0; k < 4; ++k) wn[k] = *(const u32x4*)(wp + (size_t)t1c * NPAIR + 4 * k); \
                gn = *(const f32x4*)(ada_ptr(p, l, t1c, 5) + dof); xn = *(const u32x2*)(p.xb + (size_t)t1c * D_MODEL + dof); } \
            const int t2 = t1 + step; { const int t2c = t2 < ntok ? t2 : t; ia2 = *(const u32x4*)(ip + (size_t)t2c * NPAIR); ib2 = *(const u32x4*)(ip + (size_t)t2c * NPAIR + 8); } \
            f32x4 dd; g4_out_compute(RC, wc, r, dd); \
            { f32x4 ov = (f32x4){__uint_as_float(xc.x << 16), __uint_as_float(xc.x & 0xffff0000u), __uint_as_float(xc.y << 16), __uint_as_float(xc.y & 0xffff0000u)} + gc * dd; DBG_SCALE(ov); \
              if (last) *(f32x4*)(p.out + (size_t)t * D_MODEL + dof) = ov; else { u32x2 w; w.x = pk_bf16(ov[0], ov[1]); w.y = pk_bf16(ov[2], ov[3]); *(u32x2*)(p.xb + (size_t)t * D_MODEL + dof) = w; } } \
            _Pragma("unroll") for (int k = 0; k < 4; ++k) wc[k] = wn[k]; gc = gn; xc = xn; ia1 = ia2; ib1 = ib2; t = t1; t1 = t2; }
        while (t < ntok) { G4O_STEP(ra, rb); if (t >= ntok) break; G4O_STEP(rb, ra); }
#undef G4O_STEP
    }
}

#ifndef PROBE_DUP
#define PROBE_DUP 0
#endif
#define DUP(bit) for (int _d = 0; _d < (((PROBE_DUP) >> (bit)) & 1) + 1; ++_d)
struct DevRunner {
    const P& p; const XcdBarrier& b; LAS unsigned char* lds;
    __device__ __forceinline__ void prologue() { DUP(7) { phase_ada(p, lds); phase_weights(p, lds); phase_wsb(p); phase_rope_table(p); phase_peer_tables4(p); xcd_barrier(b); } }
    __device__ __forceinline__ void norm_first() { DUP(6) { phase_norm(p, 0, 0, NT, true); xcd_barrier(b); } }
    __device__ __forceinline__ void norm2(int l, long nt2) { DUP(6) { phase_norm(p, l, 1, (int)nt2, false); xcd_barrier(b); } }
    __device__ __forceinline__ void even_mixer(int l) { DUP(4) { phase_even_mixer(p, lds, l); xcd_barrier(b); } }
    __device__ __forceinline__ void odd_conformer(int l) { DUP(5) { phase_conformer(p, lds, l); } }
    __device__ __forceinline__ void odd_attention(int l) { DUP(2) { phase_attn_prep(p, l); xcd_barrier(b); phase_attention(p, lds, l); xcd_barrier(b); } }
    __device__ __forceinline__ void peer_topk(int l, long nt2) { DUP(3) { phase_peer_topk(p, lds, l, (int)nt2); xcd_barrier(b); } }
    __device__ __forceinline__ void peer_gather(int l, long nt2) {
        DUP(1) { phase_gather4_dots(p, l, (int)nt2); xcd_barrier(b); phase_gather4_w(p, l, (int)nt2); xcd_barrier(b); }
        phase_gather4_out(p, l, (int)nt2);
        if (l != DEPTH - 1) { xcd_barrier(b); phase_norm(p, l + 1, 0, NT, false); xcd_barrier(b); } }
    __device__ __forceinline__ void gemm_in(int l) {
        const bool part = (l == DEPTH - 1) && (l & 1);
        pg8::Gemm g{p.h, p.wt_in + (size_t)l * IN_W * D_MODEL, NT, IN_W, D_MODEL}; pg8::XcdOrder S; S.init(part ? NLAT / 256 : NT / 256, NT / 256, IN_W / 256, 3 * MIX_W / 256);
        DUP(0) { pg8::gemm_phase<pg8::EpiStoreBf16, pg8::XcdOrder, true, true>(lds + 1024, g, S, pg8::EpiStoreBf16{p.bufA, IN_W, (l % 2 == 0) ? 3 * MIX_W : (1 << 30), p.vss, (l % 2 == 0) ? 4 * MIX_W : (1 << 30)}); xcd_barrier(b); } }
    __device__ __forceinline__ void gemm_out(int l, long nt2) {
        const int ntm = (l == 0) ? NLAT / 256 : (int)(nt2 / 256);
        pg8::Gemm g{p.h, p.wt_out + (size_t)l * D_MODEL * 2 * MIX_W, (int)nt2, D_MODEL, 2 * MIX_W}; pg8::XcdOrder S; S.init(ntm, ntm, D_MODEL / 256, 0);
        if ((PROBE_DUP) & 1) { pg8::gemm_phase<pg8::EpiResidual, pg8::XcdOrder, true, true>(lds + 1024, g, S, pg8::EpiResidual{p.x, p.ctx, l == 0 ? (const bf16_t*)nullptr : p.xb, (bf16_t*)p.bufB, p.ada, l}); xcd_barrier(b); }
        pg8::gemm_phase<pg8::EpiResidual, pg8::XcdOrder, true, true>(lds + 1024, g, S, pg8::EpiResidual{p.x, p.ctx, l == 0 ? (const bf16_t*)nullptr : p.xb, p.xb, p.ada, l});
        if (l == 0) gemm_small<1>(lds, p.h, p.wt_out, 2 * MIX_W, NLAT, NCTX / 128, D_MODEL / 64, EpiRes{p.x, p.ctx, p.xb, p.ada, 0});
        xcd_barrier(b); }
    __device__ __forceinline__ void gemm_q(int l, long nt2) {
        const int ntm = (l == 0) ? NLAT / 256 : (int)(nt2 / 256);
        pg8::Gemm g{p.h, p.wt_q + (size_t)l * PQW * D_MODEL, (int)nt2, PQW, D_MODEL}; pg8::XcdOrder S; S.init(ntm, ntm, PQW / 256, 0);
        DUP(0) { pg8::gemm_phase<pg8::EpiStoreBf16, pg8::XcdOrder, true, true>(lds + 1024, g, S, pg8::EpiStoreBf16{p.bufA, PQW, 1 << 30, p.vss, 1 << 30});
            if (l == 0) gemm_small<2>(lds, p.h, p.wt_q, D_MODEL, NLAT, NCTX / 128, PQW / 128, EpiBf16{p.bufA, PQW});
            xcd_barrier(b); } }
    template <nv_body_t F> __device__ __forceinline__ void run(long n, int l, int aux) {
        const long stride = (long)gridDim.x * NTHREADS;
        for (long g = (long)blockIdx.x * NTHREADS + tid_opaque(); g < n; g += stride) F(g, p, l, aux);
        xcd_barrier(b);
    }
};

__global__ void __launch_bounds__(NTHREADS, 2) megakernel(P p) {
    __shared__ __attribute__((aligned(16))) unsigned char lds[LDS_BYTES];
    volatile LAS unsigned* st = (volatile LAS unsigned*)(LAS unsigned char*)lds;
    if (threadIdx.x < 4) st[threadIdx.x] = 0u;
    __syncthreads();
    const XcdBarrier b = xcd_barrier_post(p.bar, st);
    DevRunner r{p, b, (LAS unsigned char*)lds};
    naive_forward(r, p);
}

extern "C" void kernel_launch(void* const* d_in, const int* in_sizes, int n_in, void* d_out, int out_size, void* d_ws, size_t ws_size, hipStream_t stream) {
    P p{};
    const float** ip = (const float**)&p.x;
    for (int i = 0; i < 24; ++i) ip[i] = (const float*)d_in[i];
    p.out = (float*)d_out;
    const size_t need = carve_ws(p, (char*)d_ws);
    if (need > ws_size) return;
    static int grid = 0;
    if (grid == 0) { int dev = 0, cus = 0; hipGetDevice(&dev); hipDeviceGetAttribute(&cus, hipDeviceAttributeMultiprocessorCount, dev); grid = cus > 0 ? cus : 256; }
    (void)hipMemsetAsync(p.bar, 0, (size_t)BAR_ALLOC_WORDS * 4, stream);
    hipLaunchKernelGGL(megakernel, dim3(grid), dim3(NTHREADS), 0, stream, p);
}
#endif
```
